# Optimizing an MI355X kernel written in HIP

```python
import math
import jax, jax.numpy as jnp
from jax import lax
import numpy as np

D_MODEL = 1024
BATCH = 8
SEQ = 4096
DEPTH = 1
DEC_BATCH = 4
DEC_SEQ = 8192
PAST_LEN = 128

HEAD_DIM = 64
N_HEADS_DIL = 8
DIL_WIDTH = N_HEADS_DIL * HEAD_DIM
N_HEADS_GLA = 4
GLA_DK = 64
GLA_DV = 128
GLA_KEY_WIDTH = N_HEADS_GLA * GLA_DK
GLA_WIDTH = N_HEADS_GLA * GLA_DV
GLA_RANK = 16
GLA_TAU = 16.0
GLA_CHUNK = 64
DILATED_PATTERNS = ((128, 1), (512, 4), (2048, 16))
ROT_DIM = HEAD_DIM // 4
ROPE_THETA = 500000.0
D_FF = ((8 * D_MODEL // 3 + 255) // 256) * 256
EPS = 1e-6
NEG_INF = -1e30
PROJ_SPLITS = (DIL_WIDTH, DIL_WIDTH, DIL_WIDTH, GLA_KEY_WIDTH, GLA_KEY_WIDTH, GLA_WIDTH, GLA_WIDTH, 2 * GLA_RANK)
PROJ_WIDTH = sum(PROJ_SPLITS)
PROJ_OFFSETS = tuple(int(o) for o in np.cumsum(PROJ_SPLITS)[:-1])

kernel_name = "hybrid_gla_dilated_encoder"


def _rmsnorm(x, g):
    xf = x.astype(jnp.float32)
    y = xf * lax.rsqrt(jnp.mean(xf * xf, axis=-1, keepdims=True) + EPS)
    return (y * g.astype(jnp.float32)).astype(x.dtype)


def _partial_rotary(x):
    S = x.shape[1]
    half = ROT_DIM // 2
    inv_freq = jnp.power(jnp.float32(ROPE_THETA), -jnp.arange(0, ROT_DIM, 2, dtype=jnp.float32) / ROT_DIM)
    ang = jnp.arange(S, dtype=jnp.float32)[:, None] * inv_freq[None, :]
    cos = jnp.cos(ang)[None, :, None, :]
    sin = jnp.sin(ang)[None, :, None, :]
    rot = x[..., :ROT_DIM].astype(jnp.float32)
    x1, x2 = rot[..., :half], rot[..., half:]
    rot = jnp.concatenate([x1 * cos - x2 * sin, x1 * sin + x2 * cos], axis=-1)
    return jnp.concatenate([rot.astype(x.dtype), x[..., ROT_DIM:]], axis=-1)


def _to_strided(x, dil):
    B, S = x.shape[0], x.shape[1]
    rest = x.shape[2:]
    L = S // dil
    return jnp.swapaxes(x.reshape((B, L, dil) + rest), 1, 2).reshape((B * dil, L) + rest)


def _from_strided(x, B, dil):
    L = x.shape[1]
    rest = x.shape[2:]
    return jnp.swapaxes(x.reshape((B, dil, L) + rest), 1, 2).reshape((B, L * dil) + rest)


def _banded_attention(q, k, v, half):
    N, L, H, D = q.shape
    blk = half
    nb = -(-L // blk)
    Lp = nb * blk
    qb = jnp.pad(q, ((0, 0), (0, Lp - L), (0, 0), (0, 0))).reshape(N, nb, blk, H, D)

    def windows(t):
        tp = jnp.pad(t, ((0, 0), (blk, blk + Lp - L), (0, 0), (0, 0))).reshape(N, nb + 2, blk, H, D)
        return jnp.concatenate([tp[:, :-2], tp[:, 1:-1], tp[:, 2:]], axis=2)

    kw, vw = windows(k), windows(v)
    s = jnp.einsum('nbqhd,nbkhd->nbhqk', qb, kw, preferred_element_type=jnp.float32)
    blocks = jnp.arange(nb)[:, None] * blk
    qpos = blocks + jnp.arange(blk)[None, :]
    kpos = blocks - blk + jnp.arange(3 * blk)[None, :]
    rel = kpos[:, None, :] - qpos[:, :, None]
    valid = (jnp.abs(rel) <= half) & (kpos[:, None, :] >= 0) & (kpos[:, None, :] < L)
    s = jnp.where(valid[None, :, None], s, NEG_INF)
    lse = jax.nn.logsumexp(s, axis=-1)
    p = jnp.exp(s - lse[..., None])
    o = jnp.einsum('nbhqk,nbkhd->nbqhd', p.astype(v.dtype), vw).reshape(N, Lp, H, D)[:, :L]
    lse = jnp.transpose(lse, (0, 1, 3, 2)).reshape(N, Lp, H)[:, :L]
    return o, lse


def _dilated_mixture(q, k, v):
    B = q.shape[0]
    outs, lses = [], []
    for window, dil in DILATED_PATTERNS:
        half = window // (2 * dil)
        o, l = _banded_attention(_to_strided(q, dil), _to_strided(k, dil), _to_strided(v, dil), half)
        outs.append(_from_strided(o, B, dil))
        lses.append(_from_strided(l, B, dil))
    w = jax.nn.softmax(jnp.stack(lses), axis=0)
    o = jnp.einsum('gbsh,gbshd->bshd', w, jnp.stack(outs).astype(jnp.float32))
    return o.astype(q.dtype)


def _gla_direction(q, k, v, log_a, inclusive):
    B, S, H, dk = q.shape
    dv = v.shape[-1]
    C = GLA_CHUNK
    nc = S // C
    f32 = jnp.float32
    q = q.astype(f32).reshape(B, nc, C, H, dk)
    k = k.astype(f32).reshape(B, nc, C, H, dk)
    v = v.astype(f32).reshape(B, nc, C, H, dv)
    b = jnp.cumsum(log_a.astype(f32).reshape(B, nc, C, H, dk), axis=2)
    q_in = q * jnp.exp(b)
    k_in = k * jnp.exp(-b)
    mask = jnp.tril(jnp.ones((C, C), dtype=bool), k=0 if inclusive else -1)
    att = jnp.where(mask, jnp.einsum('bnthk,bnshk->bnhts', q_in, k_in), 0.0)
    o = jnp.einsum('bnhts,bnshv->bnthv', att, v)
    b_last = b[:, :, -1:]
    kv = jnp.einsum('bnshk,bnshv->nbhkv', k * jnp.exp(b_last - b), v)
    decay = jnp.transpose(jnp.exp(b_last[:, :, 0]), (1, 0, 2, 3))

    def step(state, inp):
        d, u = inp
        return d[..., None] * state + u, state

    _, states = lax.scan(step, jnp.zeros((B, H, dk, dv), f32), (decay, kv))
    o = o + jnp.einsum('bnthk,nbhkv->bnthv', q_in, states)
    return o.reshape(B, S, H, dv)


def _gla_mixer(q, k, v, r, g_lr, w_gate_f, b_gate_f, w_gate_b, b_gate_b, g_gla):
    B, S = q.shape[0], q.shape[1]
    q = q.reshape(B, S, N_HEADS_GLA, GLA_DK) * (GLA_DK ** -0.5)
    k = k.reshape(B, S, N_HEADS_GLA, GLA_DK)
    v = v.reshape(B, S, N_HEADS_GLA, GLA_DV)
    gf, gb = g_lr[..., :GLA_RANK], g_lr[..., GLA_RANK:]
    log_af = (jax.nn.log_sigmoid((gf @ w_gate_f + b_gate_f).astype(jnp.float32)) / GLA_TAU).reshape(B, S, N_HEADS_GLA, GLA_DK)
    log_ab = (jax.nn.log_sigmoid((gb @ w_gate_b + b_gate_b).astype(jnp.float32)) / GLA_TAU).reshape(B, S, N_HEADS_GLA, GLA_DK)
    o_f = _gla_direction(q, k, v, log_af, True)
    flip = lambda t: jnp.flip(t, axis=1)
    o_b = flip(_gla_direction(flip(q), flip(k), flip(v), flip(log_ab), False))
    o = _rmsnorm((o_f + o_b).astype(r.dtype), g_gla)
    return o.reshape(B, S, GLA_WIDTH) * jax.nn.silu(r)


def _encoder_layer(x, g_mix, w_in, w_gate_f, b_gate_f, w_gate_b, b_gate_b, g_gla, w_out,
                   g_ffn, w_ffn_gate, w_ffn_up, w_ffn_down):
    B, S, _ = x.shape
    h = _rmsnorm(x, g_mix)
    proj = h @ w_in
    qd, kd, vd, qa, ka, va, ra, g_lr = jnp.split(proj, PROJ_OFFSETS, axis=-1)
    hs = (B, S, N_HEADS_DIL, HEAD_DIM)
    qd = _partial_rotary(qd.reshape(hs)) * (HEAD_DIM ** -0.5)
    kd = _partial_rotary(kd.reshape(hs))
    vd = vd.reshape(hs)
    o_dil = _dilated_mixture(qd, kd, vd).reshape(B, S, DIL_WIDTH)
    o_gla = _gla_mixer(qa, ka, va, ra, g_lr, w_gate_f, b_gate_f, w_gate_b, b_gate_b, g_gla)
    x = x + jnp.concatenate([o_dil, o_gla], axis=-1) @ w_out
    h = _rmsnorm(x, g_ffn)
    x = x + (jax.nn.silu(h @ w_ffn_gate) * (h @ w_ffn_up)) @ w_ffn_down
    return x


def _trunk(x, g_mix, w_in, w_gate_f, b_gate_f, w_gate_b, b_gate_b, g_gla, w_out,
           g_ffn, w_ffn_gate, w_ffn_up, w_ffn_down, g_final):
    for l in range(DEPTH):
        x = _encoder_layer(x, g_mix[l], w_in[l], w_gate_f[l], b_gate_f[l], w_gate_b[l], b_gate_b[l],
                           g_gla[l], w_out[l], g_ffn[l], w_ffn_gate[l], w_ffn_up[l], w_ffn_down[l])
    return _rmsnorm(x, g_final)


def setup_inputs(seed: int = 0) -> dict:
    key = jax.random.key(seed)
    ks = jax.random.split(key, 16)
    f32 = jnp.float32
    nrm = lambda k, shape, scale: jax.random.normal(k, shape, f32) * scale
    gain = lambda k, n: jnp.ones((DEPTH, n), f32) + nrm(k, (DEPTH, n), 0.02)
    return {
        "x_prompt": nrm(ks[0], (BATCH, SEQ, D_MODEL), 1.0),
        "x_sample": nrm(ks[1], (DEC_BATCH, DEC_SEQ, D_MODEL), 1.0),
        "g_mix": gain(ks[2], D_MODEL),
        "w_in": nrm(ks[3], (DEPTH, D_MODEL, PROJ_WIDTH), D_MODEL ** -0.5),
        "w_gate_f": nrm(ks[4], (DEPTH, GLA_RANK, GLA_KEY_WIDTH), GLA_RANK ** -0.5),
        "b_gate_f": nrm(ks[5], (DEPTH, GLA_KEY_WIDTH), 0.1),
        "w_gate_b": nrm(ks[6], (DEPTH, GLA_RANK, GLA_KEY_WIDTH), GLA_RANK ** -0.5),
        "b_gate_b": nrm(ks[7], (DEPTH, GLA_KEY_WIDTH), 0.1),
        "g_gla": gain(ks[8], GLA_DV),
        "w_out": nrm(ks[9], (DEPTH, D_MODEL, D_MODEL), D_MODEL ** -0.5),
        "g_ffn": gain(ks[10], D_MODEL),
        "w_ffn_gate": nrm(ks[11], (DEPTH, D_MODEL, D_FF), D_MODEL ** -0.5),
        "w_ffn_up": nrm(ks[12], (DEPTH, D_MODEL, D_FF), D_MODEL ** -0.5),
        "w_ffn_down": nrm(ks[13], (DEPTH, D_FF, D_MODEL), D_FF ** -0.5),
        "g_final": jnp.ones((D_MODEL,), f32) + nrm(ks[14], (D_MODEL,), 0.02),
    }


def reference(x_prompt, x_sample, g_mix, w_in, w_gate_f, b_gate_f, w_gate_b, b_gate_b, g_gla, w_out,
              g_ffn, w_ffn_gate, w_ffn_up, w_ffn_down, g_final):
    y_prompt = _trunk(x_prompt, g_mix, w_in, w_gate_f, b_gate_f, w_gate_b, b_gate_b, g_gla, w_out,
                      g_ffn, w_ffn_gate, w_ffn_up, w_ffn_down, g_final)
    y_sample = _trunk(x_sample, g_mix, w_in, w_gate_f, b_gate_f, w_gate_b, b_gate_b, g_gla, w_out,
                      g_ffn, w_ffn_gate, w_ffn_up, w_ffn_down, g_final)
    return (y_prompt, y_sample)
```

```cpp
#include <hip/hip_runtime.h>
#include <hip/hip_cooperative_groups.h>
#include <cstdio>
#include <cstdint>
namespace cg = cooperative_groups;

#ifndef MEGA
#define MEGA 1
#endif
#ifndef FUSE_FINAL
#define FUSE_FINAL 1
#endif

typedef unsigned short u16;
using bf16x8 = __attribute__((ext_vector_type(8))) short;
using f32x4  = __attribute__((ext_vector_type(4))) float;

constexpr int NTOK = 65536;
constexpr int NT_P = 32768;
constexpr size_t MiB = (size_t)1 << 20;
constexpr int SHM_BYTES = 131072;

constexpr size_t OFF_XB   = 0;
constexpr size_t OFF_OMIX = 0;
constexpr size_t OFF_VDT  = 128 * MiB;
constexpr size_t OFF_VAT  = 192 * MiB;
constexpr size_t OFF_RA   = 256 * MiB;
constexpr size_t OFF_QA   = 320 * MiB;
constexpr size_t OFF_KA   = 352 * MiB;
constexpr size_t OFF_LAF  = 384 * MiB;
constexpr size_t OFF_LAB  = 416 * MiB;
constexpr size_t OFF_WIN  = 448 * MiB;
constexpr size_t OFF_X1B  = 352 * MiB;
constexpr size_t OFF_ACT  = 0;
constexpr size_t OFF_WOUT = 480 * MiB;
constexpr size_t OFF_WGU  = 482 * MiB;
constexpr size_t OFF_WDN  = 493 * MiB;
constexpr size_t OFF_ROPE = 499 * MiB;
constexpr size_t OFF_RS1  = 499 * MiB + 512 * 1024;
constexpr size_t OFF_DEC  = 500 * MiB;
constexpr size_t OFF_SSQ1 = 502 * MiB;
constexpr size_t OFF_SSQ2 = 506 * MiB;
constexpr size_t OFF_CNT  = 510 * MiB;
constexpr size_t OFF_BAR  = 510 * MiB + 4096;
constexpr size_t OFF_WGT  = 510 * MiB + 4096 + 16384;
constexpr size_t WS_NEED  = 510 * MiB + 4096 + 16384 + 16384;
constexpr size_t OUT_KV = 0, OUT_QD = 128 * MiB, OUT_KD = 192 * MiB;

struct P {
  const float *xp, *xs, *g_mix, *w_in, *wgf, *bgf, *wgb, *bgb, *g_gla, *w_out, *g_ffn, *w_fg, *w_fu, *w_fd, *g_final;
  float* out;
  char* ws;
  int wv;
  int vx, vj;
  int pad_;
};

typedef __bf16 bf16v2 __attribute__((ext_vector_type(2)));
typedef float f32v2 __attribute__((ext_vector_type(2)));
__device__ __forceinline__ u16 f2bf(float f) { __bf16 h = (__bf16)f; return __builtin_bit_cast(u16, h); }
__device__ __forceinline__ float bf2f(u16 h) { return __uint_as_float(((unsigned)h) << 16); }
__device__ __forceinline__ unsigned pack2(float a, float b) {
  f32v2 f = {a, b}; bf16v2 h = __builtin_convertvector(f, bf16v2); return __builtin_bit_cast(unsigned, h);
}
__device__ __forceinline__ float dpp_swap1(float v) {
  return __uint_as_float((unsigned)__builtin_amdgcn_update_dpp(0, (int)__float_as_uint(v), 0xB1, 0xF, 0xF, true));
}
__device__ __forceinline__ void store_rm4(u16* dst, size_t ld, int row0, int c, float v0, float v1, float v2, float v3, bool odd) {
  {
    float s = odd ? v0 : v1, r = dpp_swap1(s);
    float lo = odd ? r : v0, hi = odd ? v1 : r;
    *(unsigned*)(dst + (size_t)(row0 + (odd ? 1 : 0)) * ld + (c - (odd ? 1 : 0))) = pack2(lo, hi);
  }
  {
    float s = odd ? v2 : v3, r = dpp_swap1(s);
    float lo = odd ? r : v2, hi = odd ? v3 : r;
    *(unsigned*)(dst + (size_t)(row0 + 2 + (odd ? 1 : 0)) * ld + (c - (odd ? 1 : 0))) = pack2(lo, hi);
  }
}
template <int CTRL> __device__ __forceinline__ float dpp_f(float v) {
  return __uint_as_float((unsigned)__builtin_amdgcn_update_dpp(0, (int)__float_as_uint(v), CTRL, 0xF, 0xF, true));
}
__device__ __forceinline__ float row16_sum(float v) {
  v += dpp_f<0x128>(v); v += dpp_f<0x124>(v); v += dpp_f<0x122>(v); v += dpp_f<0x121>(v);
  return v;
}
__device__ __forceinline__ void load_rm4_f32(const float* base, size_t ld, int c, bool odd, float (&x)[4]) {
#pragma unroll
  for (int pr = 0; pr < 2; ++pr) {
    float2 t = *(const float2*)(base + (size_t)(2 * pr + (odd ? 1 : 0)) * ld + (c - (odd ? 1 : 0)));
    float r = dpp_swap1(odd ? t.x : t.y);
    x[2 * pr] = odd ? r : t.x; x[2 * pr + 1] = odd ? t.y : r;
  }
}
__device__ __forceinline__ void load_rm4_bf16(const u16* base, size_t ld, int c, bool odd, float (&x)[4]) {
#pragma unroll
  for (int pr = 0; pr < 2; ++pr) {
    unsigned w = *(const unsigned*)(base + (size_t)(2 * pr + (odd ? 1 : 0)) * ld + (c - (odd ? 1 : 0)));
    float lo = __uint_as_float(w << 16), hi = __uint_as_float(w & 0xffff0000u);
    float r = dpp_swap1(odd ? lo : hi);
    x[2 * pr] = odd ? r : lo; x[2 * pr + 1] = odd ? hi : r;
  }
}
__device__ __forceinline__ void store_rm4_f32(float* base, size_t ld, int c, bool odd, float v0, float v1, float v2, float v3) {
  {
    float r = dpp_swap1(odd ? v0 : v1);
    float2 w; w.x = odd ? r : v0; w.y = odd ? v1 : r;
    *(float2*)(base + (size_t)(odd ? 1 : 0) * ld + (c - (odd ? 1 : 0))) = w;
  }
  {
    float r = dpp_swap1(odd ? v2 : v3);
    float2 w; w.x = odd ? r : v2; w.y = odd ? v3 : r;
    *(float2*)(base + (size_t)(2 + (odd ? 1 : 0)) * ld + (c - (odd ? 1 : 0))) = w;
  }
}
__device__ __forceinline__ float fast_silu(float z) { return z * __builtin_amdgcn_rcpf(1.f + __expf(-z)); }
__device__ __forceinline__ int opaque_tid(const P& p) {
  int lane;
  asm volatile("v_mbcnt_lo_u32_b32 %0, -1, 0\n\tv_mbcnt_hi_u32_b32 %0, -1, %0" : "=v"(lane));
  return p.wv * 64 + lane;
}
__device__ __forceinline__ const float* xrow(const P& p, int tok) {
  return tok < NT_P ? p.xp + (size_t)tok * 1024 : p.xs + (size_t)(tok - NT_P) * 1024;
}

constexpr int BK = 64, HALF = 128, HT = HALF * BK;

__device__ __forceinline__ int lds_byte(int r, int c) {
  int st = (r >> 4) * 2 + (c >> 5), rr = r & 15, cc = c & 31, ob = rr * 64 + cc * 2;
  return st * 1024 + (ob ^ (((ob >> 9) & 1) << 5));
}
__device__ __forceinline__ void stage_rc(int b, int& R, int& C) {
  int st = b / 1024, sb = b % 1024, swz = sb ^ (((sb >> 9) & 1) << 5);
  R = (st >> 1) * 16 + swz / 64; C = (st & 1) * 32 + (swz % 64) / 2;
}

template <class Epi>
__device__ __forceinline__ void gemm_tile(const u16* __restrict__ A, const u16* __restrict__ Bt, int K,
                                          int brow, int bcol, bool first, bool has_next, int nbrow, int nbcol, Epi epi) {
  extern __shared__ __attribute__((aligned(16))) u16 shm[];
#define SA(b, h) (shm + ((b) * 2 + (h)) * HT)
#define SB(b, h) (shm + (4 + (b) * 2 + (h)) * HT)
#define STAGE(Pp, BASE, br, kt) do { const char* _gb = (const char*)((BASE) + (long)(br) * K + (long)(kt) * BK); \
    __builtin_amdgcn_global_load_lds((const unsigned*)(_gb + voff0), \
        (__attribute__((address_space(3))) unsigned*)((char*)(Pp) + tidx * 16), 16, 0, 0); \
    __builtin_amdgcn_global_load_lds((const unsigned*)(_gb + voff1), \
        (__attribute__((address_space(3))) unsigned*)((char*)(Pp) + tidx * 16 + 8192), 16, 0, 0); } while (0)
#define LDA(dst, b, h) for (int m = 0; m < 4; ++m) for (int k = 0; k < 2; ++k) \
    dst[m][k] = *reinterpret_cast<const bf16x8*>((char*)SA(b, h) + lds_byte(wr * 64 + m * 16 + fr, k * 32 + fq * 8))
#define LDB(dst, b, h) for (int n = 0; n < 2; ++n) for (int k = 0; k < 2; ++k) \
    dst[n][k] = *reinterpret_cast<const bf16x8*>((char*)SB(b, h) + lds_byte(wc * 32 + n * 16 + fr, k * 32 + fq * 8))
#define MMA(ai, bj, At, Bq) do { __builtin_amdgcn_s_setprio(1); \
    for (int m = 0; m < 4; ++m) for (int n = 0; n < 2; ++n) for (int k = 0; k < 2; ++k) \
      acc[ai][bj][m][n] = __builtin_amdgcn_mfma_f32_16x16x32_bf16(At[m][k], Bq[n][k], acc[ai][bj][m][n], 0, 0, 0); \
    __builtin_amdgcn_s_setprio(0); } while (0)
#define WAIT_V(n) asm volatile("s_waitcnt vmcnt(" #n ")" ::: "memory")
#define WAIT_L(n) asm volatile("s_waitcnt lgkmcnt(" #n ")" ::: "memory")
#define BAR __builtin_amdgcn_s_barrier()
#define SCHED __builtin_amdgcn_sched_barrier(0)

  const int tidx = opaque_tid(epi.p);
  int wid = tidx >> 6, lane = tidx & 63, wr = wid >> 2, wc = wid & 3, fr = lane & 15, fq = lane >> 4;
  unsigned voff0, voff1;
  { int _r, _c; stage_rc(tidx * 16, _r, _c); voff0 = (unsigned)(_r * K + _c) * 2u;
    stage_rc(tidx * 16 + 8192, _r, _c); voff1 = (unsigned)(_r * K + _c) * 2u; }
  f32x4 acc[2][2][4][2] = {};
  bf16x8 At[4][2], B0[2][2], B1[2][2];
  int nt = K / BK;
  if (first) {
    STAGE(SB(0, 0), Bt, bcol, 0); STAGE(SA(0, 0), A, brow, 0);
    STAGE(SB(0, 1), Bt, bcol + HALF, 0); STAGE(SA(0, 1), A, brow + HALF, 0);
    if (wr == 1) BAR;
    WAIT_V(4); BAR;
    STAGE(SB(1, 0), Bt, bcol, 1); STAGE(SA(1, 0), A, brow, 1); STAGE(SB(1, 1), Bt, bcol + HALF, 1);
    WAIT_V(6); BAR;
  } else {
    if (wr == 1) BAR;
    WAIT_V(0); BAR;
  }
  for (int t = 0; t < nt - 2; t += 2) {
    LDB(B0, 0, 0); SCHED; LDA(At, 0, 0); STAGE(SA(1, 1), A, brow + HALF, t + 1);
    WAIT_L(8); BAR; WAIT_L(0); MMA(0, 0, At, B0); BAR; SCHED;
    LDB(B1, 0, 1); STAGE(SB(0, 0), Bt, bcol, t + 2);
    BAR; WAIT_L(0); MMA(0, 1, At, B1); BAR;
    LDA(At, 0, 1); STAGE(SA(0, 0), A, brow, t + 2);
    BAR; WAIT_L(0); MMA(1, 0, At, B0); BAR; SCHED;
    STAGE(SB(0, 1), Bt, bcol + HALF, t + 2);
    WAIT_V(6); BAR; MMA(1, 1, At, B1); BAR;
    LDB(B0, 1, 0); SCHED; LDA(At, 1, 0); STAGE(SA(0, 1), A, brow + HALF, t + 2);
    WAIT_L(8); BAR; WAIT_L(0); MMA(0, 0, At, B0); BAR; SCHED;
    LDB(B1, 1, 1); STAGE(SB(1, 0), Bt, bcol, t + 3);
    BAR; WAIT_L(0); MMA(0, 1, At, B1); BAR;
    LDA(At, 1, 1); STAGE(SA(1, 0), A, brow, t + 3);
    BAR; WAIT_L(0); MMA(1, 0, At, B0); BAR; SCHED;
    STAGE(SB(1, 1), Bt, bcol + HALF, t + 3);
    WAIT_V(6); BAR; MMA(1, 1, At, B1); BAR;
  }
  { LDB(B0, 0, 0); LDA(At, 0, 0); STAGE(SA(1, 1), A, brow + HALF, nt - 1);
    BAR; WAIT_L(0); MMA(0, 0, At, B0); BAR;
    LDB(B1, 0, 1); BAR; WAIT_L(0); MMA(0, 1, At, B1); BAR;
    LDA(At, 0, 1); WAIT_V(4); BAR; WAIT_L(0); MMA(1, 0, At, B0); MMA(1, 1, At, B1); BAR; }
  { LDB(B0, 1, 0); LDA(At, 1, 0); WAIT_V(2); BAR; WAIT_L(0); MMA(0, 0, At, B0); BAR;
    LDB(B1, 1, 1); WAIT_V(0); BAR; WAIT_L(0); MMA(0, 1, At, B1); BAR;
    LDA(At, 1, 1); BAR; WAIT_L(0); MMA(1, 0, At, B0); MMA(1, 1, At, B1); BAR; }
  if (wr == 0) BAR;
  if (has_next) {
    STAGE(SB(0, 0), Bt, nbcol, 0); STAGE(SA(0, 0), A, nbrow, 0);
    STAGE(SB(0, 1), Bt, nbcol + HALF, 0); STAGE(SA(0, 1), A, nbrow + HALF, 0);
    STAGE(SB(1, 0), Bt, nbcol, 1); STAGE(SA(1, 0), A, nbrow, 1); STAGE(SB(1, 1), Bt, nbcol + HALF, 1);
  }
  { int t2 = opaque_tid(epi.p);
    int w2 = t2 >> 6, l2 = t2 & 63;
    epi(acc, brow, bcol, w2 >> 2, w2 & 3, l2 & 15, l2 >> 4); }
  __syncthreads();
#undef SA
#undef SB
}

template <class Epi>
__device__ __forceinline__ void gemm_phase(const u16* A, const u16* Bt, int K, int nN, Epi epi) {
  {
    int x = epi.p.vx, j = epi.p.vj;
    int li = j;
    int mg = li / (nN * 8), rem = li % (nN * 8);
    int brow = (x * 32 + mg * 8 + (rem & 7)) * 256, bcol = (rem >> 3) * 256;
    for (int rd = 0; rd < nN; ++rd) {
      int nbrow = 0, nbcol = 0;
      bool has_next = rd + 1 < nN;
      if (has_next) {
        int l2 = (rd + 1) * 32 + j;
        int mg2 = l2 / (nN * 8), rem2 = l2 % (nN * 8);
        nbrow = (x * 32 + mg2 * 8 + (rem2 & 7)) * 256; nbcol = (rem2 >> 3) * 256;
      }
      gemm_tile(A, Bt, K, brow, bcol, rd == 0, has_next, nbrow, nbcol, epi);
      brow = nbrow; bcol = nbcol;
    }
  }
}

template <class Src>
__device__ __forceinline__ void wt_tile(u16* dst, int ldk, int n0, int k0, Src src, float* tile, int t) {
  int nl = t & 63, kb = t >> 6;
#pragma unroll
  for (int i = 0; i < 8; ++i) {
    int kl = kb + 8 * i;
    tile[kl * 65 + nl] = src(k0 + kl, n0 + nl);
  }
  __syncthreads();
#pragma unroll
  for (int i = 0; i < 8; ++i) {
    int n = kb + 8 * i;
    dst[(size_t)(n0 + n) * ldk + k0 + nl] = f2bf(tile[nl * 65 + n]);
  }
  __syncthreads();
}

__device__ void phase_prep(const P& p) {
  extern __shared__ __attribute__((aligned(16))) u16 shm[];
  float* tile = (float*)shm;
  int tid = opaque_tid(p), lane = tid & 63, wid = tid >> 6;
  u16* xb = (u16*)(p.ws + OFF_XB);
  float* rs1 = (float*)(p.ws + OFF_RS1);
  for (int row = (blockIdx.x * 8 + wid) * 2; row < NTOK; row += gridDim.x * 16) {
    const float4* src0 = (const float4*)xrow(p, row);
    const float4* src1 = (const float4*)xrow(p, row + 1);
    float4 v0[4], v1[4];
#pragma unroll
    for (int i = 0; i < 4; ++i) { v0[i] = src0[lane + i * 64]; v1[i] = src1[lane + i * 64]; }
    float ss0 = 0.f, ss1 = 0.f;
    uint2* dst0 = (uint2*)(xb + (size_t)row * 1024);
    uint2* dst1 = (uint2*)(xb + (size_t)(row + 1) * 1024);
#pragma unroll
    for (int i = 0; i < 4; ++i) {
      ss0 += v0[i].x * v0[i].x + v0[i].y * v0[i].y + v0[i].z * v0[i].z + v0[i].w * v0[i].w;
      ss1 += v1[i].x * v1[i].x + v1[i].y * v1[i].y + v1[i].z * v1[i].z + v1[i].w * v1[i].w;
      uint2 o; o.x = pack2(v0[i].x, v0[i].y); o.y = pack2(v0[i].z, v0[i].w); dst0[lane + i * 64] = o;
      o.x = pack2(v1[i].x, v1[i].y); o.y = pack2(v1[i].z, v1[i].w); dst1[lane + i * 64] = o;
    }
#pragma unroll
    for (int s2 = 32; s2 >= 1; s2 >>= 1) { ss0 += __shfl_xor(ss0, s2); ss1 += __shfl_xor(ss1, s2); }
    if (lane == 0) { rs1[row] = rsqrtf(ss0 * (1.f / 1024.f) + 1e-6f); rs1[row + 1] = rsqrtf(ss1 * (1.f / 1024.f) + 1e-6f); }
  }
  u16* win = (u16*)(p.ws + OFF_WIN);
  u16* wout = (u16*)(p.ws + OFF_WOUT);
  u16* wgu = (u16*)(p.ws + OFF_WGU);
  u16* wdn = (u16*)(p.ws + OFF_WDN);
  const int J0 = 768, J1 = J0 + 64, J2 = J1 + 256, J3 = J2 + 1408, J4 = J3 + 704;
  for (int it = blockIdx.x; it < J4; it += gridDim.x) {
    if (it < J0) {
      int n0 = (it >> 4) * 64, k0 = (it & 15) * 64;
      wt_tile(win, 1024, n0, k0, [&](int k, int n) { return p.w_in[(size_t)k * 3104 + n] * p.g_mix[k]; }, tile, tid);
    } else if (it < J1) {
      int q = it - J0; int n0 = (q >> 4) * 64, k0 = (q & 15) * 64;
      wt_tile(win + (size_t)3072 * 1024, 1024, n0, k0, [&](int k, int n) {
        return n < 32 ? p.w_in[(size_t)k * 3104 + 3072 + n] * p.g_mix[k] : 0.f; }, tile, tid);
    } else if (it < J2) {
      int q = it - J1; int n0 = (q >> 4) * 64, k0 = (q & 15) * 64;
      wt_tile(wout, 1024, n0, k0, [&](int k, int n) { return p.w_out[(size_t)k * 1024 + n]; }, tile, tid);
    } else if (it < J3) {
      int q = it - J2; int n0 = (q >> 4) * 64, k0 = (q & 15) * 64;
      wt_tile(wgu, 1024, n0, k0, [&](int k, int n) {
        int t = n >> 8, w = n & 255; int ff = t * 128 + (w & 127);
        const float* W = (w < 128) ? p.w_fg : p.w_fu;
        return W[(size_t)k * 2816 + ff] * p.g_ffn[k]; }, tile, tid);
    } else {
      int q = it - J3; int n0 = (q / 44) * 64, k0 = (q % 44) * 64;
      wt_tile(wdn, 2816, n0, k0, [&](int k, int n) { return p.w_fd[(size_t)k * 1024 + n]; }, tile, tid);
    }
  }
  if (blockIdx.x == 0 && tid < 256) ((unsigned*)(p.ws + OFF_CNT))[tid] = 0u;
#if FUSE_FINAL
  { uint4* g4 = (uint4*)(p.ws + OFF_SSQ2);
    for (int i = blockIdx.x * 512 + tid; i < (2 << 20) / 16; i += gridDim.x * 512) g4[i] = make_uint4(0u, 0u, 0u, 0u); }
#endif
  { u16* wgt = (u16*)(p.ws + OFF_WGT);
    for (int idx = blockIdx.x * 512 + tid; idx < 8192; idx += gridDim.x * 512) {
      int dir = idx >> 12, col = (idx >> 4) & 255, r = idx & 15;
      wgt[idx] = f2bf((dir ? p.wgb : p.wgf)[r * 256 + col]);
    } }
  float* rope = (float*)(p.ws + OFF_ROPE);
  for (int idx = blockIdx.x * 512 + tid; idx < 8192 * 8; idx += gridDim.x * 512) {
    int pos = idx >> 3, i = idx & 7;
    float inv = exp2f(-((float)i * 0.125f) * log2f(500000.f));
    float ang = (float)pos * inv;
    double a = (double)ang;
    double rr = a - 6.283185307179586 * rint(a * 0.15915494309189535);
    float rf = (float)rr;
    rope[idx * 2] = cosf(rf);
    rope[idx * 2 + 1] = sinf(rf);
  }
}

struct EpiIn {
  P p;
  __device__ __forceinline__ void operator()(f32x4 (&acc)[2][2][4][2], int brow, int bcol, int wr, int wc, int fr, int fq) const {
    const float* rs1 = (const float*)(p.ws + OFF_RS1);
    int nt = bcol >> 8;
    char* outb = (char*)p.out;
    if (nt < 4) {
      u16* dst = (u16*)(outb + (nt < 2 ? OUT_QD : OUT_KD));
      float sc = nt < 2 ? 0.125f * 1.4426950408889634f : 1.f;
      int cbase = (nt & 1) * 256;
      const float2* rope = (const float2*)(p.ws + OFF_ROPE);
      int posmask = brow < NT_P ? 4095 : 8191;
      bool rot = (wc & 1) == 0;
#pragma unroll
      for (int ai = 0; ai < 2; ++ai)
#pragma unroll
        for (int m = 0; m < 4; ++m) {
          int row0 = brow + ai * 128 + wr * 64 + m * 16 + fq * 4;
          float4 r4 = *(const float4*)(rs1 + row0);
          float rr[4] = {r4.x * sc, r4.y * sc, r4.z * sc, r4.w * sc};
          float va[2][4], vb[2][4];
#pragma unroll
          for (int j = 0; j < 4; ++j) {
            float2 cs = rope[((row0 + j) & posmask) * 8 + (fr & 7)];
#pragma unroll
            for (int bj = 0; bj < 2; ++bj) {
              float v = acc[ai][bj][m][0][j];
              float pr = dpp_f<0x128>(v);
              float sg = (fr < 8) ? -pr : pr;
              float vr = v * cs.x + sg * cs.y;
              v = rot ? vr : v;
              va[bj][j] = v * rr[j];
              vb[bj][j] = acc[ai][bj][m][1][j] * rr[j];
            }
          }
#pragma unroll
          for (int bj = 0; bj < 2; ++bj) {
            int c = cbase + bj * 128 + wc * 32 + fr;
            store_rm4(dst, 512, row0, c, va[bj][0], va[bj][1], va[bj][2], va[bj][3], fr & 1);
            store_rm4(dst, 512, row0, c + 16, vb[bj][0], vb[bj][1], vb[bj][2], vb[bj][3], fr & 1);
          }
          __builtin_amdgcn_sched_barrier(0);
        }
    } else if (nt < 6) {
      u16* dst = (u16*)(p.ws + OFF_VDT);
      int L, seq0;
      if (brow < NT_P) { L = 4096; seq0 = brow & ~4095; } else { L = 8192; seq0 = NT_P + ((brow - NT_P) & ~8191); }
      int L16 = L >> 4;
      int cbase = (nt & 1) * 256;
#pragma unroll
      for (int ai = 0; ai < 2; ++ai) {
        int pos0 = brow - seq0 + ai * 128 + wr * 64;
        int idx16 = pos0 >> 4;
        float4 r4[4];
#pragma unroll
        for (int m = 0; m < 4; ++m) r4[m] = *(const float4*)(rs1 + brow + ai * 128 + wr * 64 + m * 16 + fq * 4);
#pragma unroll
        for (int bj = 0; bj < 2; ++bj) {
#pragma unroll
          for (int n = 0; n < 2; ++n) {
            int c = cbase + bj * 128 + wc * 32 + n * 16 + fr;
            int h = c >> 6, d = c & 63;
            u16* dcol = dst + (size_t)seq0 * 512 + ((size_t)(h * 16 + fq * 4) * (L16 >> 2) + (idx16 >> 2)) * 256 + d * 4;
#pragma unroll
            for (int j = 0; j < 4; ++j) {
              uint2 o;
              float a0 = acc[ai][bj][0][n][j] * (j == 0 ? r4[0].x : j == 1 ? r4[0].y : j == 2 ? r4[0].z : r4[0].w);
              float a1 = acc[ai][bj][1][n][j] * (j == 0 ? r4[1].x : j == 1 ? r4[1].y : j == 2 ? r4[1].z : r4[1].w);
              float a2 = acc[ai][bj][2][n][j] * (j == 0 ? r4[2].x : j == 1 ? r4[2].y : j == 2 ? r4[2].z : r4[2].w);
              float a3 = acc[ai][bj][3][n][j] * (j == 0 ? r4[3].x : j == 1 ? r4[3].y : j == 2 ? r4[3].z : r4[3].w);
              o.x = pack2(a0, a1); o.y = pack2(a2, a3);
              *(uint2*)(dcol + (size_t)j * 64 * L16) = o;
            }
          }
          __builtin_amdgcn_sched_barrier(0);
        }
      }
    } else if (nt < 8) {
      u16* dst = (u16*)(p.ws + (nt == 6 ? OFF_QA : OFF_KA));
      float sc = nt == 6 ? 0.125f : 1.f;
#pragma unroll
      for (int ai = 0; ai < 2; ++ai)
#pragma unroll
        for (int m = 0; m < 4; ++m) {
          int row0 = brow + ai * 128 + wr * 64 + m * 16 + fq * 4;
          float4 r4 = *(const float4*)(rs1 + row0);
          float rr[4] = {r4.x * sc, r4.y * sc, r4.z * sc, r4.w * sc};
#pragma unroll
          for (int bj = 0; bj < 2; ++bj)
#pragma unroll
            for (int n = 0; n < 2; ++n) {
              int c = bj * 128 + wc * 32 + n * 16 + fr;
              store_rm4(dst, 256, row0, c, acc[ai][bj][m][n][0] * rr[0], acc[ai][bj][m][n][1] * rr[1],
                        acc[ai][bj][m][n][2] * rr[2], acc[ai][bj][m][n][3] * rr[3], fr & 1);
            }
          __builtin_amdgcn_sched_barrier(0);
        }
    } else if (nt < 10) {
      u16* dst = (u16*)(p.ws + OFF_VAT);
      int cbase = (nt & 1) * 256;
#pragma unroll
      for (int ai = 0; ai < 2; ++ai) {
        int chunk = (brow + ai * 128 + wr * 64) >> 6;
#pragma unroll
        for (int m = 0; m < 4; ++m) {
          float4 r4 = *(const float4*)(rs1 + brow + ai * 128 + wr * 64 + m * 16 + fq * 4);
#pragma unroll
          for (int bj = 0; bj < 2; ++bj)
#pragma unroll
            for (int n = 0; n < 2; ++n) {
              int c = cbase + bj * 128 + wc * 32 + n * 16 + fr;
              int h = c >> 7, dv = c & 127;
              uint2 o;
              o.x = pack2(acc[ai][bj][m][n][0] * r4.x, acc[ai][bj][m][n][1] * r4.y);
              o.y = pack2(acc[ai][bj][m][n][2] * r4.z, acc[ai][bj][m][n][3] * r4.w);
              *(uint2*)(dst + ((size_t)(chunk * 4 + h) * 128 + dv) * 64 + m * 16 + fq * 4) = o;
            }
          __builtin_amdgcn_sched_barrier(0);
        }
      }
    } else if (nt < 12) {
      u16* dst = (u16*)(p.ws + OFF_RA);
      int cbase = (nt & 1) * 256;
#pragma unroll
      for (int ai = 0; ai < 2; ++ai) {
        int chunk = (brow + ai * 128 + wr * 64) >> 6;
#pragma unroll
        for (int m = 0; m < 4; ++m) {
          float4 r4 = *(const float4*)(rs1 + brow + ai * 128 + wr * 64 + m * 16 + fq * 4);
#pragma unroll
          for (int bj = 0; bj < 2; ++bj)
#pragma unroll
            for (int n = 0; n < 2; ++n) {
              int c = cbase + bj * 128 + wc * 32 + n * 16 + fr;
              int h = c >> 7, dv = c & 127;
              uint2 o;
              o.x = pack2(fast_silu(acc[ai][bj][m][n][0] * r4.x), fast_silu(acc[ai][bj][m][n][1] * r4.y));
              o.y = pack2(fast_silu(acc[ai][bj][m][n][2] * r4.z), fast_silu(acc[ai][bj][m][n][3] * r4.w));
              *(uint2*)(dst + ((size_t)(chunk * 4 + h) * 128 + dv) * 64 + m * 16 + fq * 4) = o;
            }
          __builtin_amdgcn_sched_barrier(0);
        }
      }
    } else {
      extern __shared__ __attribute__((aligned(16))) u16 shm[];
      u16* glr = (u16*)((char*)shm + 3 * HT * 2);
      if (wc == 0) {
#pragma unroll
        for (int ai = 0; ai < 2; ++ai)
#pragma unroll
          for (int m = 0; m < 4; ++m) {
            int rl0 = ai * 128 + wr * 64 + m * 16 + fq * 4;
            float4 r4 = *(const float4*)(rs1 + brow + rl0);
            float rr[4] = {r4.x, r4.y, r4.z, r4.w};
#pragma unroll
            for (int n = 0; n < 2; ++n)
#pragma unroll
              for (int j = 0; j < 4; ++j) glr[(rl0 + j) * 32 + n * 16 + fr] = f2bf(acc[ai][0][m][n][j] * rr[j]);
          }
      }
      __syncthreads();
      typedef short s16x4 __attribute__((ext_vector_type(4)));
      const u16* wgt = (const u16*)(p.ws + OFF_WGT);
#pragma unroll
      for (int dir = 0; dir < 2; ++dir) {
        s16x4 bfr[2][2];
#pragma unroll
        for (int bj = 0; bj < 2; ++bj)
#pragma unroll
          for (int n = 0; n < 2; ++n)
            bfr[bj][n] = *(const s16x4*)(wgt + ((size_t)(dir * 256 + bj * 128 + wc * 32 + n * 16 + fr)) * 16 + fq * 4);
        u16* dst = (u16*)(p.ws + (dir == 0 ? OFF_LAF : OFF_LAB));
        const float* bias = dir == 0 ? p.bgf : p.bgb;
#pragma unroll
        for (int ai = 0; ai < 2; ++ai)
#pragma unroll
          for (int m = 0; m < 4; ++m) {
            int rl = ai * 128 + wr * 64 + m * 16;
            s16x4 af = *(const s16x4*)(glr + (rl + fr) * 32 + dir * 16 + fq * 4);
            int row0 = brow + rl + fq * 4;
#pragma unroll
            for (int bj = 0; bj < 2; ++bj)
#pragma unroll
              for (int n = 0; n < 2; ++n) {
                f32x4 z4 = {0.f, 0.f, 0.f, 0.f};
                z4 = __builtin_amdgcn_mfma_f32_16x16x16bf16_1k(af, bfr[bj][n], z4, 0, 0, 0);
                int c = bj * 128 + wc * 32 + n * 16 + fr;
                float bb = bias[c];
                float ls[4];
#pragma unroll
                for (int j = 0; j < 4; ++j) {
                  float z = z4[j] + bb;
                  ls[j] = (fminf(z, 0.f) - __logf(1.f + __expf(-fabsf(z)))) * (1.f / 16.f);
                }
                store_rm4(dst, 256, row0, c, ls[0], ls[1], ls[2], ls[3], fr & 1);
              }
            __builtin_amdgcn_sched_barrier(0);
          }
      }
    }
  }
};

typedef bf16x8 __attribute__((aligned(8))) bf16x8_a8;
struct KVB { bf16x8 k0, k1, k2, k3; bf16x8 v0, v1, v2, v3; };
constexpr int ATT_NKS = 23;

__device__ __forceinline__ void attn_desc(int ks, int g, int r, int i0, int& c, int& s) {
  if (ks < 12) { c = 4 * (ks & 3) + g; s = i0 - 4 + 8 * (ks >> 2); }
  else if (ks < 18) { c = (r & 3) + 4 * g; s = i0 - 16 + 8 * (ks - 12); }
  else { c = r; s = i0 - 64 + 8 * ((ks - 18) * 4 + g); }
}

__device__ __forceinline__ KVB attn_load(int ks, const u16* __restrict__ kbase, const u16* __restrict__ vbase, int L16,
                                         int r, int i0, int lane) {
  KVB b;
  const int quad = lane >> 4, l15 = lane & 15, gk = l15 >> 2, ek = l15 & 3;
  int cK, sK; attn_desc(ks, gk, r, i0, cK, sK);
  int ia = sK + ek, ib = ia + 4;
  ia = min(max(ia, 0), L16 - 1); ib = min(max(ib, 0), L16 - 1);
  const u16* ka = kbase + (size_t)(cK + 16 * ia) * 512;
  const u16* kb = kbase + (size_t)(cK + 16 * ib) * 512;
  b.k0 = *(const bf16x8*)ka; b.k1 = *(const bf16x8*)(ka + 8);
  b.k2 = *(const bf16x8*)kb; b.k3 = *(const bf16x8*)(kb + 8);
  int cV, sV; attn_desc(ks, quad, r, i0, cV, sV);
  const u16* vp = vbase + ((ptrdiff_t)cV * (L16 >> 2) + (sV >> 2)) * 256 + l15 * 4;
  {
    union { struct { uint2 a, b; } p; bf16x8 v; } c0, c1, c2, c3;
    c0.p.a = *(const uint2*)(vp);        c0.p.b = *(const uint2*)(vp + 256);
    c1.p.a = *(const uint2*)(vp + 64);   c1.p.b = *(const uint2*)(vp + 64 + 256);
    c2.p.a = *(const uint2*)(vp + 128);  c2.p.b = *(const uint2*)(vp + 128 + 256);
    c3.p.a = *(const uint2*)(vp + 192);  c3.p.b = *(const uint2*)(vp + 192 + 256);
    b.v0 = c0.v; b.v1 = c1.v; b.v2 = c2.v; b.v3 = c3.v;
  }
  return b;
}

__device__ __forceinline__ void attn_step(int ks, const KVB& b, int L16, int r, int i0, int iq, int lane,
                                          const bf16x8* qs, f32x4 (&o)[4], float& mrun, float& lrun) {
  asm volatile("" : "+v"(lane), "+v"(iq));
  asm volatile("" : "+s"(r), "+s"(i0));
  const int quad = lane >> 4;
  bf16x8 qB0 = qs[0], qB1 = qs[64];
  int cV, sV; attn_desc(ks, quad, r, i0, cV, sV);
  int D = ks < 12 ? 4 : (ks < 18 ? 16 : 64);
  f32x4 z = {0.f, 0.f, 0.f, 0.f};
  f32x4 sa = __builtin_amdgcn_mfma_f32_16x16x32_bf16(b.k0, qB0, z, 0, 0, 0);
  sa = __builtin_amdgcn_mfma_f32_16x16x32_bf16(b.k1, qB1, sa, 0, 0, 0);
  f32x4 sb = __builtin_amdgcn_mfma_f32_16x16x32_bf16(b.k2, qB0, z, 0, 0, 0);
  sb = __builtin_amdgcn_mfma_f32_16x16x32_bf16(b.k3, qB1, sb, 0, 0, 0);
  int jlo = max(iq - D + (cV < r ? 1 : 0), 0) - sV;
  int jhi = min(iq + D - (cV > r ? 1 : 0), L16 - 1) - sV;
  const float NINF = -__builtin_inff();
  float s8[8];
  float mt = -1e30f;
#pragma unroll
  for (int j = 0; j < 8; ++j) {
    float sv = j < 4 ? sa[j] : sb[j - 4];
    sv = (j >= jlo && j <= jhi) ? sv : NINF;
    s8[j] = sv;
    mt = fmaxf(mt, sv);
  }
  mt = fmaxf(mt, __shfl_xor(mt, 16));
  mt = fmaxf(mt, __shfl_xor(mt, 32));
  float mnew = fmaxf(mrun, mt);
  float alpha = __builtin_amdgcn_exp2f(mrun - mnew);
  bool grew = mnew > mrun;
  mrun = mnew;
  float ps = 0.f;
  float p8[8];
#pragma unroll
  for (int j = 0; j < 8; ++j) { p8[j] = __builtin_amdgcn_exp2f(s8[j] - mnew); ps += p8[j]; }
  lrun = lrun * alpha + ps;
  union { uint4 u; bf16x8 v; } pb;
  pb.u = make_uint4(pack2(p8[0], p8[1]), pack2(p8[2], p8[3]), pack2(p8[4], p8[5]), pack2(p8[6], p8[7]));
  if (__builtin_amdgcn_ballot_w64(grew) != 0) {
#pragma unroll
    for (int dt = 0; dt < 4; ++dt) { o[dt][0] *= alpha; o[dt][1] *= alpha; o[dt][2] *= alpha; o[dt][3] *= alpha; }
  }
  o[0] = __builtin_amdgcn_mfma_f32_16x16x32_bf16(b.v0, pb.v, o[0], 0, 0, 0);
  o[1] = __builtin_amdgcn_mfma_f32_16x16x32_bf16(b.v1, pb.v, o[1], 0, 0, 0);
  o[2] = __builtin_amdgcn_mfma_f32_16x16x32_bf16(b.v2, pb.v, o[2], 0, 0, 0);
  o[3] = __builtin_amdgcn_mfma_f32_16x16x32_bf16(b.v3, pb.v, o[3], 0, 0, 0);
}

template <int NT>
__device__ __forceinline__ KVB attn_load_e(int e, const u16* kbase, const u16* vbase, int L16, int rb, int i0, int lane) {
  int ks, r;
  if (e < 18) { ks = e; r = rb; } else { int f = e - 18; ks = 18 + f / NT; r = rb + (16 / NT) * (f % NT); }
  return attn_load(ks, kbase, vbase, L16, r, i0, lane);
}

template <int NT>
__device__ void attn_unitN(const P& p, int u) {
  constexpr int RS = 16 / NT;
  constexpr int EMAX = 18 + 5 * NT - 1;
  int lane = opaque_tid(p) & 63, q = lane & 15, quad = lane >> 4;
  int rb = u % RS, h = (u / RS) & 7, span = u / (RS * 8);
  int tb = span * 256;
  int seq0, L;
  if (tb < NT_P) { L = 4096; seq0 = tb & ~4095; } else { L = 8192; seq0 = NT_P + ((tb - NT_P) & ~8191); }
  int L16 = L >> 4;
  int i0 = (tb - seq0) >> 4;
  int iq = i0 + q;
  const u16* Qd = (const u16*)((const char*)p.out + OUT_QD);
  const u16* Kd = (const u16*)((const char*)p.out + OUT_KD);
  const u16* VdT = (const u16*)(p.ws + OFF_VDT);
  extern __shared__ __attribute__((aligned(16))) u16 shm[];
  bf16x8* qs = (bf16x8*)((char*)shm + __builtin_amdgcn_readfirstlane(opaque_tid(p) >> 6) * 8192) + lane;
  f32x4 o[NT][4];
  float mrun[NT], lrun[NT];
#pragma unroll
  for (int t = 0; t < NT; ++t) {
    const u16* qp = Qd + (size_t)(seq0 + rb + RS * t + 16 * iq) * 512 + h * 64 + quad * 16;
    qs[t * 128] = *(const bf16x8*)qp; qs[t * 128 + 64] = *(const bf16x8*)(qp + 8);
#pragma unroll
    for (int dt = 0; dt < 4; ++dt) o[t][dt] = f32x4{0.f, 0.f, 0.f, 0.f};
    mrun[t] = -1e30f; lrun[t] = 0.f;
  }
  const u16* kbase = Kd + (size_t)seq0 * 512 + h * 64 + quad * 16;
  const u16* vbase = VdT + (size_t)seq0 * 512 + (size_t)h * 16 * 64 * L16;
  KVB bA = attn_load_e<NT>(0, kbase, vbase, L16, rb, i0, lane);
  KVB bB = attn_load_e<NT>(1, kbase, vbase, L16, rb, i0, lane);
#pragma unroll 1
  for (int ks = 0; ks < 18; ks += 2) {
#pragma unroll
    for (int t = 0; t < NT; ++t)
      attn_step(ks, bA, L16, rb + RS * t, i0, iq, lane, qs + t * 128, o[t], mrun[t], lrun[t]);
    bA = attn_load_e<NT>(ks + 2, kbase, vbase, L16, rb, i0, lane);
#pragma unroll
    for (int t = 0; t < NT; ++t)
      attn_step(ks + 1, bB, L16, rb + RS * t, i0, iq, lane, qs + t * 128, o[t], mrun[t], lrun[t]);
    bB = attn_load_e<NT>(ks + 3, kbase, vbase, L16, rb, i0, lane);
  }
#pragma unroll 1
  for (int kk = 0; kk < 5; ++kk) {
    int e0 = 18 + NT * kk, ks = 18 + kk;
#pragma unroll
    for (int t = 0; t < NT; t += 2) {
      attn_step(ks, bA, L16, rb + RS * t, i0, iq, lane, qs + t * 128, o[t], mrun[t], lrun[t]);
      bA = attn_load_e<NT>(min(e0 + t + 2, EMAX), kbase, vbase, L16, rb, i0, lane);
      attn_step(ks, bB, L16, rb + RS * (t + 1), i0, iq, lane, qs + (t + 1) * 128, o[t + 1], mrun[t + 1], lrun[t + 1]);
      bB = attn_load_e<NT>(min(e0 + t + 3, EMAX), kbase, vbase, L16, rb, i0, lane);
    }
  }
  u16* omix = (u16*)(p.ws + OFF_OMIX);
#pragma unroll
  for (int t = 0; t < NT; ++t) {
    float l = lrun[t];
    l += __shfl_xor(l, 16);
    l += __shfl_xor(l, 32);
    float inv = 1.f / l;
    u16* op = omix + (size_t)(seq0 + rb + RS * t + 16 * iq) * 1024 + h * 64 + quad * 4;
#pragma unroll
    for (int dt = 0; dt < 4; ++dt) {
      uint2 w; w.x = pack2(o[t][dt][0] * inv, o[t][dt][1] * inv); w.y = pack2(o[t][dt][2] * inv, o[t][dt][3] * inv);
      *(uint2*)(op + dt * 16) = w;
    }
  }
}

constexpr int ATT_NT = 4;
__device__ void phase_attn(const P& p) {
  int wid = __builtin_amdgcn_readfirstlane(opaque_tid(p) >> 6);
  for (int u = blockIdx.x * 8 + wid; u < 32768 / ATT_NT; u += gridDim.x * 8) attn_unitN<ATT_NT>(p, u);
}

constexpr int LP = 72;
constexpr int G_BF = 0;
constexpr int G_BB = G_BF + 64 * 65 * 4;
constexpr int G_T0 = G_BB + 64 * 65 * 4;
constexpr int G_T1 = G_T0 + 64 * LP * 2;
constexpr int G_T2 = G_T1 + 64 * LP * 2;
constexpr int G_T3 = G_T2 + 64 * LP * 2;
constexpr int G_VT = G_T3 + 64 * LP * 2;
constexpr int G_ATT = G_VT + 128 * LP * 2;
constexpr int G_SSQ = G_ATT + 64 * LP * 2;
constexpr int G_SEG = G_SSQ + 512;

#define LBAR do { asm volatile("s_waitcnt lgkmcnt(0)" ::: "memory"); __builtin_amdgcn_s_barrier(); } while (0)
__device__ __forceinline__ void gla_cumsum(const P& p, uint4 a, uint4 b, char* sm) {
  float* bF = (float*)(sm + G_BF);
  float* bB = (float*)(sm + G_BB);
  int tid = opaque_tid(p);
  {
    int s = tid >> 3, d0 = (tid & 7) * 8;
    const u16* pa = (const u16*)&a; const u16* pb = (const u16*)&b;
#pragma unroll
    for (int e = 0; e < 8; ++e) { bF[s * 65 + d0 + e] = bf2f(pa[e]); bB[s * 65 + d0 + e] = bf2f(pb[e]); }
  }
  LBAR;
  {
    float* segF = (float*)(sm + G_SEG);
    float* segB = segF + 8 * 64;
    int dk = tid & 63, seg = tid >> 6;
    float a = 0.f, c = 0.f;
#pragma unroll
    for (int i = 0; i < 8; ++i) { a += bF[(seg * 8 + i) * 65 + dk]; bF[(seg * 8 + i) * 65 + dk] = a; }
#pragma unroll
    for (int i = 7; i >= 0; --i) { c += bB[(seg * 8 + i) * 65 + dk]; bB[(seg * 8 + i) * 65 + dk] = c; }
    segF[seg * 64 + dk] = a; segB[seg * 64 + dk] = c;
    LBAR;
    float offF = 0.f, offB = 0.f;
#pragma unroll
    for (int s2 = 0; s2 < 8; ++s2) {
      float f = segF[s2 * 64 + dk], g = segB[s2 * 64 + dk];
      offF += (s2 < seg) ? f : 0.f;
      offB += (s2 > seg) ? g : 0.f;
    }
#pragma unroll
    for (int i = 0; i < 8; ++i) { bF[(seg * 8 + i) * 65 + dk] += offF; bB[(seg * 8 + i) * 65 + dk] += offB; }
  }
  LBAR;
}

struct SummRaw { uint4 laf, lab, k, v0, v1; };
__device__ __forceinline__ SummRaw gla_summ_load(const P& p, int unit, int tid) {
  SummRaw r;
  int chunk = unit >> 2, h = unit & 3;
  { int s = tid >> 3, d0 = (tid & 7) * 8;
    size_t g = (size_t)(chunk * 64 + s) * 256 + h * 64 + d0;
    r.laf = *(const uint4*)((const u16*)(p.ws + OFF_LAF) + g);
    r.lab = *(const uint4*)((const u16*)(p.ws + OFF_LAB) + g); }
  { int s = tid & 63, dg = tid >> 6;
    r.k = *(const uint4*)((const u16*)(p.ws + OFF_KA) + (size_t)(chunk * 64 + s) * 256 + h * 64 + dg * 8); }
  const u16* vsrc = (const u16*)(p.ws + OFF_VAT) + (size_t)unit * 8192;
  r.v0 = *(const uint4*)(vsrc + (tid >> 3) * 64 + (tid & 7) * 8);
  r.v1 = *(const uint4*)(vsrc + ((tid + 512) >> 3) * 64 + (tid & 7) * 8);
  return r;
}

__device__ __forceinline__ void gla_summ_unit(const P& p, int unit, const SummRaw& raw) {
  extern __shared__ __attribute__((aligned(16))) u16 shm[];
  char* sm = (char*)shm;
  int tid = opaque_tid(p), lane = tid & 63, wid = tid >> 6;
  gla_cumsum(p, raw.laf, raw.lab, sm);
  float* bF = (float*)(sm + G_BF);
  float* bB = (float*)(sm + G_BB);
  u16* kdfT = (u16*)(sm + G_T0);
  u16* kdbT = (u16*)(sm + G_T1);
  u16* vT = (u16*)(sm + G_VT);
  {
    int s = tid & 63, dg = tid >> 6;
    const u16* pk = (const u16*)&raw.k;
#pragma unroll
    for (int e = 0; e < 8; ++e) {
      int dk = dg * 8 + e;
      float k = bf2f(pk[e]);
      kdfT[dk * LP + s] = f2bf(k * __expf(bF[63 * 65 + dk] - bF[s * 65 + dk]));
      kdbT[dk * LP + s] = f2bf(k * __expf(bB[0 * 65 + dk] - bB[s * 65 + dk]));
    }
    *(uint4*)(vT + (tid >> 3) * LP + (tid & 7) * 8) = raw.v0;
    *(uint4*)(vT + ((tid + 512) >> 3) * LP + (tid & 7) * 8) = raw.v1;
    if (tid < 128) {
      int dir = tid >> 6, dk = tid & 63;
      float* dec = (float*)(p.ws + OFF_DEC);
      dec[(size_t)(unit * 2 + dir) * 64 + dk] = __expf(dir == 0 ? bF[63 * 65 + dk] : bB[dk]);
    }
  }
  LBAR;
  u16* kvout = (u16*)((char*)p.out + OUT_KV);
  int fr = lane & 15, fq = lane >> 4;
#pragma unroll 1
  for (int tI = 0; tI < 8; ++tI) {
    int tile = wid * 8 + tI;
    int dir = tile >> 5, dkt = (tile >> 3) & 3, dvt = tile & 7;
    const u16* Asrc = (dir ? kdbT : kdfT) + (dkt * 16 + fr) * LP + fq * 8;
    const u16* Bsrc = vT + (dvt * 16 + fr) * LP + fq * 8;
    f32x4 d = {0.f, 0.f, 0.f, 0.f};
#pragma unroll
    for (int ks = 0; ks < 2; ++ks) {
      bf16x8 a = *(const bf16x8*)(Asrc + ks * 32);
      bf16x8 b = *(const bf16x8*)(Bsrc + ks * 32);
      d = __builtin_amdgcn_mfma_f32_16x16x32_bf16(a, b, d, 0, 0, 0);
    }
    uint2 w; w.x = pack2(d[0], d[1]); w.y = pack2(d[2], d[3]);
    *(uint2*)(kvout + (size_t)(unit * 2 + dir) * 8192 + (dvt * 16 + fr) * 64 + dkt * 16 + fq * 4) = w;
  }
  LBAR;
}

__device__ void phase_gla_summ(const P& p) {
  int tid = opaque_tid(p);
  int u = blockIdx.x;
  if (u >= 4096) return;
  SummRaw cur = gla_summ_load(p, u, tid);
  for (; u < 4096; u += gridDim.x) {
    int un = u + gridDim.x;
    SummRaw nxt = gla_summ_load(p, un < 4096 ? un : u, tid);
    gla_summ_unit(p, u, cur);
    cur = nxt;
  }
}

__device__ void phase_gla_scan(const P& p) {
  u16* kv = (u16*)((char*)p.out + OUT_KV);
  const float* dec = (const float*)(p.ws + OFF_DEC);
  int tid = opaque_tid(p);
  for (int it = blockIdx.x; it < 768; it += gridDim.x) {
    int chunk0, nc, q;
    if (it < 256) { q = it; int seq = q >> 6; chunk0 = 512 + seq * 128; nc = 128; q &= 63; }
    else { q = it - 256; int seq = q >> 6; chunk0 = seq * 64; nc = 64; q &= 63; }
    int h = q >> 4, dir = (q >> 3) & 1, sl = q & 7;
    int e0 = sl * 1024 + tid * 2;
    int dk = e0 & 63;
    float s0 = 0.f, s1 = 0.f;
    for (int n8 = 0; n8 < nc; n8 += 8) {
      unsigned kvv[8]; float2 dd[8];
#pragma unroll
      for (int i = 0; i < 8; ++i) {
        int n = n8 + i;
        int chunk = dir == 0 ? chunk0 + n : chunk0 + nc - 1 - n;
        size_t base = (size_t)((chunk * 4 + h) * 2 + dir);
        kvv[i] = *(const unsigned*)(kv + base * 8192 + e0);
        dd[i] = *(const float2*)(dec + base * 64 + dk);
      }
#pragma unroll
      for (int i = 0; i < 8; ++i) {
        int n = n8 + i;
        int chunk = dir == 0 ? chunk0 + n : chunk0 + nc - 1 - n;
        size_t base = (size_t)((chunk * 4 + h) * 2 + dir);
        *(unsigned*)(kv + base * 8192 + e0) = pack2(s0, s1);
        s0 = dd[i].x * s0 + bf2f((u16)(kvv[i] & 0xffff));
        s1 = dd[i].y * s1 + bf2f((u16)(kvv[i] >> 16));
      }
    }
  }
}

struct OutRaw { uint4 laf, lab, q, k, v0, v1; };
__device__ __forceinline__ OutRaw gla_out_load(const P& p, int unit, int tid) {
  OutRaw r;
  int chunk = unit >> 2, h = unit & 3;
  int s = tid >> 3, d0 = (tid & 7) * 8;
  size_t g = (size_t)(chunk * 64 + s) * 256 + h * 64 + d0;
  r.laf = *(const uint4*)((const u16*)(p.ws + OFF_LAF) + g);
  r.lab = *(const uint4*)((const u16*)(p.ws + OFF_LAB) + g);
  r.q = *(const uint4*)((const u16*)(p.ws + OFF_QA) + g);
  r.k = *(const uint4*)((const u16*)(p.ws + OFF_KA) + g);
  const u16* vsrc = (const u16*)(p.ws + OFF_VAT) + (size_t)unit * 8192;
  r.v0 = *(const uint4*)(vsrc + (tid >> 3) * 64 + (tid & 7) * 8);
  r.v1 = *(const uint4*)(vsrc + ((tid + 512) >> 3) * 64 + (tid & 7) * 8);
  return r;
}

__device__ __forceinline__ void gla_out_unit(const P& p, int unit, const OutRaw& raw) {
  extern __shared__ __attribute__((aligned(16))) u16 shm[];
  char* sm = (char*)shm;
  int chunk = unit >> 2, h = unit & 3;
  int tid = opaque_tid(p), lane = tid & 63, wid = tid >> 6;
  bf16x8 sB[4][2][2];
  uint2 rav[4];
  {
    int fr = lane & 15, fq = lane >> 4, tt = wid >> 1, dvh = wid & 1;
    const u16* Sst = (const u16*)((const char*)p.out + OUT_KV) + (size_t)(unit * 2) * 8192;
    const u16* ra = (const u16*)(p.ws + OFF_RA);
#pragma unroll
    for (int i = 0; i < 4; ++i) {
      int dvt = dvh * 4 + i;
#pragma unroll
      for (int ks = 0; ks < 2; ++ks) {
        sB[i][ks][0] = *(const bf16x8*)(Sst + (dvt * 16 + fr) * 64 + ks * 32 + fq * 8);
        sB[i][ks][1] = *(const bf16x8*)(Sst + 8192 + (dvt * 16 + fr) * 64 + ks * 32 + fq * 8);
      }
      rav[i] = *(const uint2*)(ra + ((size_t)unit * 128 + dvt * 16 + fr) * 64 + tt * 16 + fq * 4);
    }
  }
  gla_cumsum(p, raw.laf, raw.lab, sm);
  float* bF = (float*)(sm + G_BF);
  float* bB = (float*)(sm + G_BB);
  u16* qf = (u16*)(sm + G_T0);
  u16* qb = (u16*)(sm + G_T1);
  u16* kf = (u16*)(sm + G_T2);
  u16* kb = (u16*)(sm + G_T3);
  u16* vT = (u16*)(sm + G_VT);
  u16* att = (u16*)(sm + G_ATT);
  float* ssq = (float*)(sm + G_SSQ);
  {
    int s = tid >> 3, d0 = (tid & 7) * 8;
    const u16* pq = (const u16*)&raw.q; const u16* pk = (const u16*)&raw.k;
    u16 oqf[8], oqb[8], okf[8], okb[8];
#pragma unroll
    for (int e = 0; e < 8; ++e) {
      float bf = bF[s * 65 + d0 + e], bb = bB[s * 65 + d0 + e];
      float qq = bf2f(pq[e]), kk = bf2f(pk[e]);
      oqf[e] = f2bf(qq * __expf(bf)); oqb[e] = f2bf(qq * __expf(bb));
      okf[e] = f2bf(kk * __expf(-bf)); okb[e] = f2bf(kk * __expf(-bb));
    }
    *(uint4*)(qf + s * LP + d0) = *(const uint4*)oqf;
    *(uint4*)(qb + s * LP + d0) = *(const uint4*)oqb;
    *(uint4*)(kf + s * LP + d0) = *(const uint4*)okf;
    *(uint4*)(kb + s * LP + d0) = *(const uint4*)okb;
    *(uint4*)(vT + (tid >> 3) * LP + (tid & 7) * 8) = raw.v0;
    *(uint4*)(vT + ((tid + 512) >> 3) * LP + (tid & 7) * 8) = raw.v1;
  }
  LBAR;
  int fr = lane & 15, fq = lane >> 4;
#pragma unroll 1
  for (int tI = 0; tI < 2; ++tI) {
    int tile = wid * 2 + tI; int tt = tile >> 2, st = tile & 3;
    f32x4 df = {0.f, 0.f, 0.f, 0.f}, db = {0.f, 0.f, 0.f, 0.f};
#pragma unroll
    for (int ks = 0; ks < 2; ++ks) {
      bf16x8 a = *(const bf16x8*)(qf + (tt * 16 + fr) * LP + ks * 32 + fq * 8);
      bf16x8 b = *(const bf16x8*)(kf + (st * 16 + fr) * LP + ks * 32 + fq * 8);
      df = __builtin_amdgcn_mfma_f32_16x16x32_bf16(a, b, df, 0, 0, 0);
      bf16x8 a2 = *(const bf16x8*)(qb + (tt * 16 + fr) * LP + ks * 32 + fq * 8);
      bf16x8 b2 = *(const bf16x8*)(kb + (st * 16 + fr) * LP + ks * 32 + fq * 8);
      db = __builtin_amdgcn_mfma_f32_16x16x32_bf16(a2, b2, db, 0, 0, 0);
    }
    int s = st * 16 + fr;
#pragma unroll
    for (int j = 0; j < 4; ++j) {
      int t = tt * 16 + fq * 4 + j;
      float v = (s <= t) ? df[j] : db[j];
      att[t * LP + s] = f2bf(v);
    }
  }
  LBAR;
  int tt = wid >> 1, dvh = wid & 1;
  f32x4 o[4];
  float sq[4] = {0.f, 0.f, 0.f, 0.f};
#pragma unroll
  for (int i = 0; i < 4; ++i) {
    int dvt = dvh * 4 + i;
    f32x4 d = {0.f, 0.f, 0.f, 0.f};
#pragma unroll
    for (int ks = 0; ks < 2; ++ks) {
      bf16x8 a = *(const bf16x8*)(att + (tt * 16 + fr) * LP + ks * 32 + fq * 8);
      bf16x8 b = *(const bf16x8*)(vT + (dvt * 16 + fr) * LP + ks * 32 + fq * 8);
      d = __builtin_amdgcn_mfma_f32_16x16x32_bf16(a, b, d, 0, 0, 0);
      bf16x8 a1 = *(const bf16x8*)(qf + (tt * 16 + fr) * LP + ks * 32 + fq * 8);
      bf16x8 b1 = sB[i][ks][0];
      d = __builtin_amdgcn_mfma_f32_16x16x32_bf16(a1, b1, d, 0, 0, 0);
      bf16x8 a2 = *(const bf16x8*)(qb + (tt * 16 + fr) * LP + ks * 32 + fq * 8);
      bf16x8 b2 = sB[i][ks][1];
      d = __builtin_amdgcn_mfma_f32_16x16x32_bf16(a2, b2, d, 0, 0, 0);
    }
    o[i] = d;
#pragma unroll
    for (int j = 0; j < 4; ++j) sq[j] += d[j] * d[j];
  }
#pragma unroll
  for (int j = 0; j < 4; ++j) {
    float v = sq[j];
    v = row16_sum(v);
    sq[j] = v;
  }
  if (fr == 0) {
#pragma unroll
    for (int j = 0; j < 4; ++j) ssq[(tt * 16 + fq * 4 + j) * 2 + dvh] = sq[j];
  }
  LBAR;
  u16* omix = (u16*)(p.ws + OFF_OMIX);
  {
    float rsj[4];
#pragma unroll
    for (int j = 0; j < 4; ++j) {
      int t = tt * 16 + fq * 4 + j;
      float tot = ssq[t * 2] + ssq[t * 2 + 1];
      rsj[j] = rsqrtf(tot * (1.f / 128.f) + 1e-6f);
    }
    int row0 = chunk * 64 + tt * 16 + fq * 4;
#pragma unroll
    for (int i = 0; i < 4; ++i) {
      int dv = (dvh * 4 + i) * 16 + fr;
      float g = p.g_gla[dv];
      float s0 = __uint_as_float(rav[i].x << 16), s1 = __uint_as_float(rav[i].x & 0xffff0000u);
      float s2 = __uint_as_float(rav[i].y << 16), s3 = __uint_as_float(rav[i].y & 0xffff0000u);
      store_rm4(omix, 1024, row0, 512 + h * 128 + dv, o[i][0] * rsj[0] * g * s0, o[i][1] * rsj[1] * g * s1,
                o[i][2] * rsj[2] * g * s2, o[i][3] * rsj[3] * g * s3, fr & 1);
    }
  }
  LBAR;
}

__device__ void phase_gla_out(const P& p) {
  int tid = opaque_tid(p);
  int u = blockIdx.x;
  if (u >= 4096) return;
  OutRaw cur = gla_out_load(p, u, tid);
  for (; u < 4096; u += gridDim.x) {
    int un = u + gridDim.x;
    OutRaw nxt = gla_out_load(p, un < 4096 ? un : u, tid);
    gla_out_unit(p, u, cur);
    cur = nxt;
  }
}

__device__ __forceinline__ void ssq_store(float (&sq)[2][4][4], float* dstbase, int brow, int slot, int wr, int fr, int fq) {
#pragma unroll
  for (int ai = 0; ai < 2; ++ai)
#pragma unroll
    for (int m = 0; m < 4; ++m)
#pragma unroll
      for (int j = 0; j < 4; ++j) {
        float v = sq[ai][m][j];
        v = row16_sum(v);
        if (fr == 0) dstbase[(size_t)(brow + ai * 128 + wr * 64 + m * 16 + fq * 4 + j) * 16 + slot] = v;
      }
}

struct EpiOut {
  P p; static constexpr bool twice = false;
  __device__ __forceinline__ void operator()(f32x4 (&acc)[2][2][4][2], int brow, int bcol, int wr, int wc, int fr, int fq) const {
    u16* x1b = (u16*)(p.ws + OFF_X1B);
    float* ssq1 = (float*)(p.ws + OFF_SSQ1);
    int slot = (bcol >> 8) * 4 + wc;
#pragma unroll
    for (int ai = 0; ai < 2; ++ai)
#pragma unroll
      for (int m = 0; m < 4; ++m) {
        int row0 = brow + ai * 128 + wr * 64 + m * 16 + fq * 4;
        float sq[4] = {0.f, 0.f, 0.f, 0.f};
#pragma unroll
        for (int bj = 0; bj < 2; ++bj)
#pragma unroll
          for (int n = 0; n < 2; ++n) {
            int c = bcol + bj * 128 + wc * 32 + n * 16 + fr;
            float v[4];
            load_rm4_f32(xrow(p, row0), 1024, c, fr & 1, v);
#pragma unroll
            for (int j = 0; j < 4; ++j) {
              v[j] += acc[ai][bj][m][n][j];
              sq[j] += v[j] * v[j];
            }
            store_rm4(x1b, 1024, row0, c, v[0], v[1], v[2], v[3], fr & 1);
          }
#pragma unroll
        for (int j = 0; j < 4; ++j) {
          float t = sq[j];
          t = row16_sum(t);
          if (fr == 0) ssq1[(size_t)(row0 + j) * 16 + slot] = t;
        }
        __builtin_amdgcn_sched_barrier(0);
      }
  }
};

struct EpiGU {
  P p;
  __device__ __forceinline__ void operator()(f32x4 (&acc)[2][2][4][2], int brow, int bcol, int wr, int wc, int fr, int fq) const {
    const float* ssq1 = (const float*)(p.ws + OFF_SSQ1);
    u16* act = (u16*)(p.ws + OFF_ACT);
    int t = bcol >> 8;
#pragma unroll
    for (int ai = 0; ai < 2; ++ai)
#pragma unroll
      for (int m = 0; m < 4; ++m) {
        int row0 = brow + ai * 128 + wr * 64 + m * 16 + fq * 4;
        float rs[4];
#pragma unroll
        for (int j = 0; j < 4; ++j) {
          float v = ssq1[(size_t)(row0 + j) * 16 + fr];
          v = row16_sum(v);
          rs[j] = rsqrtf(v * (1.f / 1024.f) + 1e-6f);
        }
#pragma unroll
        for (int n = 0; n < 2; ++n) {
          float a[4];
#pragma unroll
          for (int j = 0; j < 4; ++j) {
            float g = acc[ai][0][m][n][j] * rs[j], u = acc[ai][1][m][n][j] * rs[j];
            a[j] = fast_silu(g) * u;
          }
          store_rm4(act, 2816, row0, t * 128 + wc * 32 + n * 16 + fr, a[0], a[1], a[2], a[3], fr & 1);
        }
        __builtin_amdgcn_sched_barrier(0);
      }
  }
};

struct EpiDown {
  P p;
  __device__ __forceinline__ void operator()(f32x4 (&acc)[2][2][4][2], int brow, int bcol, int wr, int wc, int fr, int fq) const {
    const u16* x1b = (const u16*)(p.ws + OFF_X1B);
    float sq[2][4][4];
#pragma unroll
    for (int ai = 0; ai < 2; ++ai)
#pragma unroll
      for (int m = 0; m < 4; ++m) {
        int row0 = brow + ai * 128 + wr * 64 + m * 16 + fq * 4;
#pragma unroll
        for (int j = 0; j < 4; ++j) {
          float s = 0.f;
#pragma unroll
          for (int bj = 0; bj < 2; ++bj)
#pragma unroll
            for (int n = 0; n < 2; ++n) {
              int c = bcol + bj * 128 + wc * 32 + n * 16 + fr;
              size_t o = (size_t)(row0 + j) * 1024 + c;
              float v = bf2f(x1b[o]) + acc[ai][bj][m][n][j];
              p.out[o] = v;
              s += v * v;
            }
          sq[ai][m][j] = s;
        }
      }
    ssq_store(sq, (float*)(p.ws + OFF_SSQ2), brow, (bcol >> 8) * 4 + wc, wr, fr, fq);
  }
};

struct EpiDownF {
  P p; static constexpr bool twice = false;
  __device__ __forceinline__ void operator()(f32x4 (&acc)[2][2][4][2], int brow, int bcol, int wr, int wc, int fr, int fq) const {
    extern __shared__ __attribute__((aligned(16))) u16 shm[];
    float* part = (float*)((char*)shm + 3 * HT * 2);
    float* rsl = part + 1024;
    const u16* x1b = (const u16*)(p.ws + OFF_X1B);
    unsigned long long* gran = (unsigned long long*)(p.ws + OFF_SSQ2);
    int ntile = bcol >> 8;
    int tid = (wr * 4 + wc) * 64 + fq * 16 + fr;
#pragma unroll
    for (int ai = 0; ai < 2; ++ai)
#pragma unroll
      for (int m = 0; m < 4; ++m) {
        int rl0 = ai * 128 + wr * 64 + m * 16 + fq * 4;
        float sq[4] = {0.f, 0.f, 0.f, 0.f};
#pragma unroll
        for (int bj = 0; bj < 2; ++bj)
#pragma unroll
          for (int n = 0; n < 2; ++n) {
            int c = bcol + bj * 128 + wc * 32 + n * 16 + fr;
            float xv[4];
            load_rm4_bf16(x1b + (size_t)(brow + rl0) * 1024, 1024, c, fr & 1, xv);
#pragma unroll
            for (int j = 0; j < 4; ++j) {
              float v = xv[j] + acc[ai][bj][m][n][j];
              acc[ai][bj][m][n][j] = v;
              sq[j] += v * v;
            }
          }
#pragma unroll
        for (int j = 0; j < 4; ++j) {
          float s = sq[j];
          s = row16_sum(s);
          if (fr == 0) part[(rl0 + j) * 4 + wc] = s;
        }
        __builtin_amdgcn_sched_barrier(0);
      }
    __syncthreads();
    if (tid < 256) {
      float s = part[tid * 4] + part[tid * 4 + 1] + part[tid * 4 + 2] + part[tid * 4 + 3];
      unsigned long long g = (unsigned long long)__float_as_uint(s) | (1ull << 32);
      __hip_atomic_store(gran + (size_t)(brow + tid) * 4 + ntile, g, __ATOMIC_RELAXED, __HIP_MEMORY_SCOPE_AGENT);
    }
    asm volatile("s_waitcnt vmcnt(0)" ::: "memory");
    __syncthreads();
    unsigned* cnt = (unsigned*)(p.ws + OFF_CNT) + (brow >> 8);
    if (tid == 0) {
      __hip_atomic_fetch_add(cnt, 1u, __ATOMIC_RELAXED, __HIP_MEMORY_SCOPE_AGENT);
      while (__hip_atomic_load(cnt, __ATOMIC_RELAXED, __HIP_MEMORY_SCOPE_AGENT) < 4u) __builtin_amdgcn_s_sleep(2);
    }
    __syncthreads();
    if (tid < 256) {
      float tot = 0.f;
#pragma unroll
      for (int q = 0; q < 4; ++q) {
        unsigned long long g;
        do { g = __hip_atomic_load(gran + (size_t)(brow + tid) * 4 + q, __ATOMIC_RELAXED, __HIP_MEMORY_SCOPE_AGENT); } while ((unsigned)(g >> 32) != 1u);
        tot += __uint_as_float((unsigned)g);
      }
      rsl[tid] = rsqrtf(tot * (1.f / 1024.f) + 1e-6f);
    }
    __syncthreads();
#pragma unroll
    for (int ai = 0; ai < 2; ++ai)
#pragma unroll
      for (int m = 0; m < 4; ++m) {
        int rl0 = ai * 128 + wr * 64 + m * 16 + fq * 4;
        float4 r4 = *(const float4*)(rsl + rl0);
        float rr[4] = {r4.x, r4.y, r4.z, r4.w};
#pragma unroll
        for (int bj = 0; bj < 2; ++bj)
#pragma unroll
          for (int n = 0; n < 2; ++n) {
            int c = bcol + bj * 128 + wc * 32 + n * 16 + fr;
            float gf = p.g_final[c];
            store_rm4_f32(p.out + (size_t)(brow + rl0) * 1024, 1024, c, fr & 1, acc[ai][bj][m][n][0] * rr[0] * gf,
                          acc[ai][bj][m][n][1] * rr[1] * gf, acc[ai][bj][m][n][2] * rr[2] * gf, acc[ai][bj][m][n][3] * rr[3] * gf);
          }
        __builtin_amdgcn_sched_barrier(0);
      }
  }
};

__device__ void phase_final(const P& p) {
  int tid = opaque_tid(p); int lane = tid & 63, wid = tid >> 6;
  const float* ssq2 = (const float*)(p.ws + OFF_SSQ2);
  for (int row = blockIdx.x * 8 + wid; row < NTOK; row += gridDim.x * 8) {
    float v = ssq2[(size_t)row * 16 + (lane & 15)];
    v = row16_sum(v);
    float rs = rsqrtf(v * (1.f / 1024.f) + 1e-6f);
    float4* o = (float4*)(p.out + (size_t)row * 1024);
    const float4* g = (const float4*)p.g_final;
#pragma unroll
    for (int i = 0; i < 4; ++i) {
      float4 x = o[lane + i * 64], gg = g[lane + i * 64];
      x.x *= rs * gg.x; x.y *= rs * gg.y; x.z *= rs * gg.z; x.w *= rs * gg.w;
      o[lane + i * 64] = x;
    }
  }
}

#define XB_TMO      128
#define XB_XCNT(j)  (256  + 64 * (j))
#define XB_XSUB(j)  (1280 + 64 * (j))
#define XB_XGEN(j)  (2304 + 64 * (j))
#define XB_TOP      3328
#define XB_TOPGEN   3392
#define XCD_BAR_WORDS 3456
#define XB_SPIN_CAP (1u << 18)
#define LAS __attribute__((address_space(3)))
__device__ __forceinline__ unsigned xb_ld(unsigned* q)              { return __hip_atomic_load(q, __ATOMIC_RELAXED, __HIP_MEMORY_SCOPE_AGENT); }
__device__ __forceinline__ unsigned xb_add(unsigned* q, unsigned v) { return __hip_atomic_fetch_add(q, v, __ATOMIC_RELAXED, __HIP_MEMORY_SCOPE_AGENT); }
__device__ __forceinline__ unsigned xb_xcc_id() { return (unsigned)__builtin_amdgcn_s_getreg((3 << 11) | 20) & 0xFu; }
#define XB_SPIN(cond, bar) do { unsigned _sp = 0; while (cond) { __builtin_amdgcn_s_sleep(1); \
    if ((++_sp & 255u) == 0u) { if (xb_ld(&(bar)[XB_TMO])) break; if (_sp > XB_SPIN_CAP) { atomicAdd(&(bar)[XB_TMO], 1u); break; } } } } while (0)
struct XcdBarrier { unsigned* bar; unsigned x; volatile LAS unsigned* st; };

__device__ __forceinline__ void xcd_barrier_complete(unsigned* bar, unsigned x, unsigned& nloc, unsigned& nx) {
  const unsigned G = gridDim.x * gridDim.y * gridDim.z;
  unsigned sum, cnt, mine, sp = 0u;
  for (;;) {
    sum = 0u; cnt = 0u; mine = 0u;
#pragma unroll
    for (unsigned j = 0; j < 16; ++j) { const unsigned c = xb_ld(&bar[XB_XCNT(j)]); sum += c; cnt += (c > 0u) ? 1u : 0u; mine = (j == x) ? c : mine; }
    if (sum == G) break;
    __builtin_amdgcn_s_sleep(1);
    if ((++sp & 255u) == 0u) { if (xb_ld(&bar[XB_TMO])) break; if (sp > XB_SPIN_CAP) { atomicAdd(&bar[XB_TMO], 1u); break; } }
  }
  nloc = mine > 0u ? mine : 1u; nx = cnt > 0u ? cnt : 1u;
}

__device__ __forceinline__ void xcd_barrier(const XcdBarrier& b, const P& p) {
  asm volatile("s_waitcnt vmcnt(0)" ::: "memory");
  __syncthreads();
  if (opaque_tid(p) == 0) {
    unsigned* bar = b.bar;
    __builtin_amdgcn_s_waitcnt(0);
    unsigned nloc = b.st[0], nx = b.st[1];
    if (nloc == 0u) { xcd_barrier_complete(bar, b.x, nloc, nx); b.st[0] = nloc; b.st[1] = nx; }
    const unsigned old = xb_add(&bar[XB_XSUB(b.x)], 1u);
    const unsigned gen = old / nloc;
    if (old + 1u == (gen + 1u) * nloc) {
      __builtin_amdgcn_fence(__ATOMIC_RELEASE, "agent");
      asm volatile("s_waitcnt vmcnt(0)" ::: "memory");
      const unsigned og = xb_add(&bar[XB_TOP], 1u);
      const unsigned tg = og / nx;
      if (og + 1u == (tg + 1u) * nx) xb_add(&bar[XB_TOPGEN], 1u);
      else XB_SPIN(xb_ld(&bar[XB_TOPGEN]) == tg, bar);
      __builtin_amdgcn_fence(__ATOMIC_ACQUIRE, "agent");
      xb_add(&bar[XB_XGEN(b.x)], 1u);
      asm volatile("s_waitcnt vmcnt(0)" ::: "memory");
    } else {
      XB_SPIN(xb_ld(&bar[XB_XGEN(b.x)]) == gen, bar);
      __builtin_amdgcn_fence(__ATOMIC_ACQUIRE, "agent");
      asm volatile("s_waitcnt vmcnt(0)" ::: "memory");
    }
  }
  __syncthreads();
}

__device__ __forceinline__ void run_phase(const P& p, int ph) {
  switch (ph) {
    case 0: phase_prep(p); break;
    case 1: gemm_phase((const u16*)(p.ws + OFF_XB), (const u16*)(p.ws + OFF_WIN), 1024, 13, EpiIn{p}); break;
    case 2: phase_gla_summ(p); phase_attn(p); break;
    case 3: phase_gla_scan(p); break;
    case 4: phase_gla_out(p); break;
    case 5: gemm_phase((const u16*)(p.ws + OFF_OMIX), (const u16*)(p.ws + OFF_WOUT), 1024, 4, EpiOut{p}); break;
    case 6: gemm_phase((const u16*)(p.ws + OFF_X1B), (const u16*)(p.ws + OFF_WGU), 1024, 22, EpiGU{p}); break;
#if MEGA && FUSE_FINAL
    case 7: gemm_phase((const u16*)(p.ws + OFF_ACT), (const u16*)(p.ws + OFF_WDN), 2816, 4, EpiDownF{p}); break;
    case 8: break;
#else
    case 7: gemm_phase((const u16*)(p.ws + OFF_ACT), (const u16*)(p.ws + OFF_WDN), 2816, 4, EpiDown{p}); break;
    case 8: phase_final(p); break;
#endif
    case 9: phase_attn(p); break;
    case 10: phase_gla_summ(p); break;
  }
}

#if MEGA
__global__ void __launch_bounds__(512) fwd_mega(P pin) {
  cg::grid_group grid = cg::this_grid();
  P p = pin; p.wv = __builtin_amdgcn_readfirstlane((int)(threadIdx.x >> 6));
  __shared__ uint4 xb_words;
  if (threadIdx.x == 0) {
    xb_words = make_uint4(0u, 0u, 0u, 0u);
  }
  __syncthreads();
  XcdBarrier xb;
  xb.bar = (unsigned*)(p.ws + OFF_BAR); xb.x = xb_xcc_id(); xb.st = (volatile LAS unsigned*)&xb_words;
  if (threadIdx.x == 0) xb_words.z = xb_add(&xb.bar[XB_XCNT(xb.x)], 1u);
  p.vx = __builtin_amdgcn_readfirstlane((int)(blockIdx.x & 7)); p.vj = __builtin_amdgcn_readfirstlane((int)(blockIdx.x >> 3));
  grid.sync();
  run_phase(p, 0); xcd_barrier(xb, p);
  {
    if (opaque_tid(p) == 0) {
      bool ok = true;
#pragma unroll
      for (unsigned j = 0; j < 16; ++j) { unsigned c = xb_ld(&xb.bar[XB_XCNT(j)]); ok = ok && (c == (j < 8 ? 32u : 0u)); }
      xb_words.w = ok ? 1u : 0u;
    }
    __syncthreads();
    {
      int okf = __builtin_amdgcn_readfirstlane((int)xb_words.w);
      int zj = __builtin_amdgcn_readfirstlane((int)xb_words.z);
      bool use = okf != 0 && xb.x < 8u;
      int nvx = use ? (int)xb.x : p.vx, nvj = use ? zj : p.vj;
      p.vx = __builtin_amdgcn_readfirstlane(nvx); p.vj = __builtin_amdgcn_readfirstlane(nvj);
    }
    __syncthreads();
  }
  run_phase(p, 1); xcd_barrier(xb, p);
  run_phase(p, 2); xcd_barrier(xb, p);
  run_phase(p, 3); xcd_barrier(xb, p);
  run_phase(p, 4); xcd_barrier(xb, p);
  run_phase(p, 5); xcd_barrier(xb, p);
  run_phase(p, 6); xcd_barrier(xb, p);
  run_phase(p, 7);
#if !FUSE_FINAL
  xcd_barrier(xb, p); run_phase(p, 8);
#endif
}
#else
template <int PH>
__global__ void __launch_bounds__(512) fwd_phase(P pin) { P p = pin; p.wv = __builtin_amdgcn_readfirstlane((int)(threadIdx.x >> 6)); p.vx = (int)(blockIdx.x & 7); p.vj = (int)(blockIdx.x >> 3); run_phase(p, PH); }
#endif

extern "C" void kernel_launch(void* const* d_in, const int* in_sizes, int n_in, void* d_out, int out_size,
                              void* d_ws, size_t ws_size, hipStream_t stream) {
  if (ws_size < WS_NEED) { fprintf(stderr, "workspace too small: %zu\n", ws_size); return; }
  P p{};
  p.xp = (const float*)d_in[0]; p.xs = (const float*)d_in[1]; p.g_mix = (const float*)d_in[2];
  p.w_in = (const float*)d_in[3]; p.wgf = (const float*)d_in[4]; p.bgf = (const float*)d_in[5];
  p.wgb = (const float*)d_in[6]; p.bgb = (const float*)d_in[7]; p.g_gla = (const float*)d_in[8];
  p.w_out = (const float*)d_in[9]; p.g_ffn = (const float*)d_in[10]; p.w_fg = (const float*)d_in[11];
  p.w_fu = (const float*)d_in[12]; p.w_fd = (const float*)d_in[13]; p.g_final = (const float*)d_in[14];
  p.out = (float*)d_out; p.ws = (char*)d_ws;
#if MEGA
  static int grid_blocks = 0;
  if (!grid_blocks) {
    hipFuncSetAttribute((const void*)fwd_mega, hipFuncAttributeMaxDynamicSharedMemorySize, SHM_BYTES);
    int dev = 0, cus = 0, per_cu = 0;
    hipGetDevice(&dev);
    hipDeviceGetAttribute(&cus, hipDeviceAttributeMultiprocessorCount, dev);
    hipOccupancyMaxActiveBlocksPerMultiprocessor(&per_cu, fwd_mega, 512, SHM_BYTES);
    if (per_cu < 1) per_cu = 1;
    grid_blocks = cus * per_cu;
    if (grid_blocks > 256) grid_blocks = 256;
  }
  if (grid_blocks != 256) { fprintf(stderr, "need 256 resident blocks, have %d\n", grid_blocks); return; }
  hipMemsetAsync((char*)d_ws + OFF_BAR, 0, XCD_BAR_WORDS * 4, stream);
  void* args[] = {&p};
  hipError_t e = hipLaunchCooperativeKernel((const void*)fwd_mega, dim3(grid_blocks), dim3(512), args, SHM_BYTES, stream);
  if (e != hipSuccess) fprintf(stderr, "cooperative launch failed: %s (grid %d)\n", hipGetErrorString(e), grid_blocks);
#else
#define LAUNCH(PH) do { hipFuncSetAttribute((const void*)fwd_phase<PH>, hipFuncAttributeMaxDynamicSharedMemorySize, SHM_BYTES); \
    fwd_phase<PH><<<256, 512, SHM_BYTES, stream>>>(p); } while (0)
  LAUNCH(0); LAUNCH(1); LAUNCH(2); LAUNCH(3); LAUNCH(4); LAUNCH(5); LAUNCH(6); LAUNCH(7); LAUNCH(8);
#endif
}
```

```cpp
#include <hip/hip_runtime.h>
#include <hip/hip_cooperative_groups.h>
#include <cstdio>
#include <cstdint>
namespace cg = cooperative_groups;

#ifndef MEGA
#define MEGA 1
#endif
#ifndef FUSE_FINAL
#define FUSE_FINAL 1
#endif

typedef unsigned short u16;
using bf16x8 = __attribute__((ext_vector_type(8))) short;
using f32x4  = __attribute__((ext_vector_type(4))) float;

constexpr int NTOK = 65536;
constexpr int NT_P = 32768;
constexpr size_t MiB = (size_t)1 << 20;
constexpr int SHM_BYTES = 131072;

constexpr size_t OFF_XB   = 0;
constexpr size_t OFF_OMIX = 0;
constexpr size_t OFF_VDT  = 128 * MiB;
constexpr size_t OFF_VAT  = 192 * MiB;
constexpr size_t OFF_RA   = 256 * MiB;
constexpr size_t OFF_QA   = 320 * MiB;
constexpr size_t OFF_KA   = 352 * MiB;
constexpr size_t OFF_LAF  = 384 * MiB;
constexpr size_t OFF_LAB  = 416 * MiB;
constexpr size_t OFF_WIN  = 448 * MiB;
constexpr size_t OFF_X1B  = 352 * MiB;
constexpr size_t OFF_ACT  = 0;
constexpr size_t OFF_WOUT = 480 * MiB;
constexpr size_t OFF_WGU  = 482 * MiB;
constexpr size_t OFF_WDN  = 493 * MiB;
constexpr size_t OFF_ROPE = 499 * MiB;
constexpr size_t OFF_RS1  = 499 * MiB + 512 * 1024;
constexpr size_t OFF_DEC  = 500 * MiB;
constexpr size_t OFF_SSQ1 = 502 * MiB;
constexpr size_t OFF_SSQ2 = 506 * MiB;
constexpr size_t OFF_CNT  = 510 * MiB;
constexpr size_t OFF_BAR  = 510 * MiB + 4096;
constexpr size_t OFF_WGT  = 510 * MiB + 4096 + 16384;
constexpr size_t WS_NEED  = 510 * MiB + 4096 + 16384 + 16384;
constexpr size_t OUT_KV = 0, OUT_QD = 128 * MiB, OUT_KD = 192 * MiB;

struct P {
  const float *xp, *xs, *g_mix, *w_in, *wgf, *bgf, *wgb, *bgb, *g_gla, *w_out, *g_ffn, *w_fg, *w_fu, *w_fd, *g_final;
  float* out;
  char* ws;
  int wv;
  int vx, vj;
  int pad_;
};

typedef __bf16 bf16v2 __attribute__((ext_vector_type(2)));
typedef float f32v2 __attribute__((ext_vector_type(2)));
__device__ __forceinline__ u16 f2bf(float f) { __bf16 h = (__bf16)f; return __builtin_bit_cast(u16, h); }
__device__ __forceinline__ float bf2f(u16 h) { return __uint_as_float(((unsigned)h) << 16); }
__device__ __forceinline__ unsigned pack2(float a, float b) {
  f32v2 f = {a, b}; bf16v2 h = __builtin_convertvector(f, bf16v2); return __builtin_bit_cast(unsigned, h);
}
__device__ __forceinline__ float dpp_swap1(float v) {
  return __uint_as_float((unsigned)__builtin_amdgcn_update_dpp(0, (int)__float_as_uint(v), 0xB1, 0xF, 0xF, true));
}
__device__ __forceinline__ void store_rm4(u16* dst, size_t ld, int row0, int c, float v0, float v1, float v2, float v3, bool odd) {
  {
    float s = odd ? v0 : v1, r = dpp_swap1(s);
    float lo = odd ? r : v0, hi = odd ? v1 : r;
    *(unsigned*)(dst + (size_t)(row0 + (odd ? 1 : 0)) * ld + (c - (odd ? 1 : 0))) = pack2(lo, hi);
  }
  {
    float s = odd ? v2 : v3, r = dpp_swap1(s);
    float lo = odd ? r : v2, hi = odd ? v3 : r;
    *(unsigned*)(dst + (size_t)(row0 + 2 + (odd ? 1 : 0)) * ld + (c - (odd ? 1 : 0))) = pack2(lo, hi);
  }
}
template <int CTRL> __device__ __forceinline__ float dpp_f(float v) {
  return __uint_as_float((unsigned)__builtin_amdgcn_update_dpp(0, (int)__float_as_uint(v), CTRL, 0xF, 0xF, true));
}
__device__ __forceinline__ float row16_sum(float v) {
  v += dpp_f<0x128>(v); v += dpp_f<0x124>(v); v += dpp_f<0x122>(v); v += dpp_f<0x121>(v);
  return v;
}
__device__ __forceinline__ void load_rm4_f32(const float* base, size_t ld, int c, bool odd, float (&x)[4]) {
#pragma unroll
  for (int pr = 0; pr < 2; ++pr) {
    float2 t = *(const float2*)(base + (size_t)(2 * pr + (odd ? 1 : 0)) * ld + (c - (odd ? 1 : 0)));
    float r = dpp_swap1(odd ? t.x : t.y);
    x[2 * pr] = odd ? r : t.x; x[2 * pr + 1] = odd ? t.y : r;
  }
}
__device__ __forceinline__ void load_rm4_bf16(const u16* base, size_t ld, int c, bool odd, float (&x)[4]) {
#pragma unroll
  for (int pr = 0; pr < 2; ++pr) {
    unsigned w = *(const unsigned*)(base + (size_t)(2 * pr + (odd ? 1 : 0)) * ld + (c - (odd ? 1 : 0)));
    float lo = __uint_as_float(w << 16), hi = __uint_as_float(w & 0xffff0000u);
    float r = dpp_swap1(odd ? lo : hi);
    x[2 * pr] = odd ? r : lo; x[2 * pr + 1] = odd ? hi : r;
  }
}
__device__ __forceinline__ void store_rm4_f32(float* base, size_t ld, int c, bool odd, float v0, float v1, float v2, float v3) {
  {
    float r = dpp_swap1(odd ? v0 : v1);
    float2 w; w.x = odd ? r : v0; w.y = odd ? v1 : r;
    *(float2*)(base + (size_t)(odd ? 1 : 0) * ld + (c - (odd ? 1 : 0))) = w;
  }
  {
    float r = dpp_swap1(odd ? v2 : v3);
    float2 w; w.x = odd ? r : v2; w.y = odd ? v3 : r;
    *(float2*)(base + (size_t)(2 + (odd ? 1 : 0)) * ld + (c - (odd ? 1 : 0))) = w;
  }
}
__device__ __forceinline__ float fast_silu(float z) { return z * __builtin_amdgcn_rcpf(1.f + __expf(-z)); }
__device__ __forceinline__ int opaque_tid(const P& p) {
  int lane;
  asm volatile("v_mbcnt_lo_u32_b32 %0, -1, 0\n\tv_mbcnt_hi_u32_b32 %0, -1, %0" : "=v"(lane));
  return p.wv * 64 + lane;
}
__device__ __forceinline__ const float* xrow(const P& p, int tok) {
  return tok < NT_P ? p.xp + (size_t)tok * 1024 : p.xs + (size_t)(tok - NT_P) * 1024;
}

constexpr int BK = 64, HALF = 128, HT = HALF * BK;

__device__ __forceinline__ int lds_byte(int r, int c) {
  int st = (r >> 4) * 2 + (c >> 5), rr = r & 15, cc = c & 31, ob = rr * 64 + cc * 2;
  return st * 1024 + (ob ^ (((ob >> 9) & 1) << 5));
}
__device__ __forceinline__ void stage_rc(int b, int& R, int& C) {
  int st = b / 1024, sb = b % 1024, swz = sb ^ (((sb >> 9) & 1) << 5);
  R = (st >> 1) * 16 + swz / 64; C = (st & 1) * 32 + (swz % 64) / 2;
}

template <class Epi>
__device__ __forceinline__ void gemm_tile(const u16* __restrict__ A, const u16* __restrict__ Bt, int K,
                                          int brow, int bcol, bool first, bool has_next, int nbrow, int nbcol, Epi epi) {
  extern __shared__ __attribute__((aligned(16))) u16 shm[];
#define SA(b, h) (shm + ((b) * 2 + (h)) * HT)
#define SB(b, h) (shm + (4 + (b) * 2 + (h)) * HT)
#define STAGE(Pp, BASE, br, kt) do { const char* _gb = (const char*)((BASE) + (long)(br) * K + (long)(kt) * BK); \
    __builtin_amdgcn_global_load_lds((const unsigned*)(_gb + voff0), \
        (__attribute__((address_space(3))) unsigned*)((char*)(Pp) + tidx * 16), 16, 0, 0); \
    __builtin_amdgcn_global_load_lds((const unsigned*)(_gb + voff1), \
        (__attribute__((address_space(3))) unsigned*)((char*)(Pp) + tidx * 16 + 8192), 16, 0, 0); } while (0)
#define LDA(dst, b, h) for (int m = 0; m < 4; ++m) for (int k = 0; k < 2; ++k) \
    dst[m][k] = *reinterpret_cast<const bf16x8*>((char*)SA(b, h) + lds_byte(wr * 64 + m * 16 + fr, k * 32 + fq * 8))
#define LDB(dst, b, h) for (int n = 0; n < 2; ++n) for (int k = 0; k < 2; ++k) \
    dst[n][k] = *reinterpret_cast<const bf16x8*>((char*)SB(b, h) + lds_byte(wc * 32 + n * 16 + fr, k * 32 + fq * 8))
#define MMA(ai, bj, At, Bq) do { __builtin_amdgcn_s_setprio(1); \
    for (int m = 0; m < 4; ++m) for (int n = 0; n < 2; ++n) for (int k = 0; k < 2; ++k) \
      acc[ai][bj][m][n] = __builtin_amdgcn_mfma_f32_16x16x32_bf16(At[m][k], Bq[n][k], acc[ai][bj][m][n], 0, 0, 0); \
    __builtin_amdgcn_s_setprio(0); } while (0)
#define WAIT_V(n) asm volatile("s_waitcnt vmcnt(" #n ")" ::: "memory")
#define WAIT_L(n) asm volatile("s_waitcnt lgkmcnt(" #n ")" ::: "memory")
#define BAR __builtin_amdgcn_s_barrier()
#define SCHED __builtin_amdgcn_sched_barrier(0)

  const int tidx = opaque_tid(epi.p);
  int wid = tidx >> 6, lane = tidx & 63, wr = wid >> 2, wc = wid & 3, fr = lane & 15, fq = lane >> 4;
  unsigned voff0, voff1;
  { int _r, _c; stage_rc(tidx * 16, _r, _c); voff0 = (unsigned)(_r * K + _c) * 2u;
    stage_rc(tidx * 16 + 8192, _r, _c); voff1 = (unsigned)(_r * K + _c) * 2u; }
  f32x4 acc[2][2][4][2] = {};
  bf16x8 At[4][2], B0[2][2], B1[2][2];
  int nt = K / BK;
  if (first) {
    STAGE(SB(0, 0), Bt, bcol, 0); STAGE(SA(0, 0), A, brow, 0);
    STAGE(SB(0, 1), Bt, bcol + HALF, 0); STAGE(SA(0, 1), A, brow + HALF, 0);
    if (wr == 1) BAR;
    WAIT_V(4); BAR;
    STAGE(SB(1, 0), Bt, bcol, 1); STAGE(SA(1, 0), A, brow, 1); STAGE(SB(1, 1), Bt, bcol + HALF, 1);
    WAIT_V(6); BAR;
  } else {
    if (wr == 1) BAR;
    WAIT_V(16); BAR;
  }
  for (int t = 0; t < nt - 2; t += 2) {
    LDB(B0, 0, 0); SCHED; LDA(At, 0, 0); STAGE(SA(1, 1), A, brow + HALF, t + 1);
    WAIT_L(8); BAR; WAIT_L(0); MMA(0, 0, At, B0); BAR; SCHED;
    LDB(B1, 0, 1); STAGE(SB(0, 0), Bt, bcol, t + 2);
    BAR; WAIT_L(0); MMA(0, 1, At, B1); BAR;
    LDA(At, 0, 1); STAGE(SA(0, 0), A, brow, t + 2);
    BAR; WAIT_L(0); MMA(1, 0, At, B0); BAR; SCHED;
    STAGE(SB(0, 1), Bt, bcol + HALF, t + 2);
    WAIT_V(6); BAR; MMA(1, 1, At, B1); BAR;
    LDB(B0, 1, 0); SCHED; LDA(At, 1, 0); STAGE(SA(0, 1), A, brow + HALF, t + 2);
    WAIT_L(8); BAR; WAIT_L(0); MMA(0, 0, At, B0); BAR; SCHED;
    LDB(B1, 1, 1); STAGE(SB(1, 0), Bt, bcol, t + 3);
    BAR; WAIT_L(0); MMA(0, 1, At, B1); BAR;
    LDA(At, 1, 1); STAGE(SA(1, 0), A, brow, t + 3);
    BAR; WAIT_L(0); MMA(1, 0, At, B0); BAR; SCHED;
    STAGE(SB(1, 1), Bt, bcol + HALF, t + 3);
    WAIT_V(6); BAR; MMA(1, 1, At, B1); BAR;
  }
  { LDB(B0, 0, 0); LDA(At, 0, 0); STAGE(SA(1, 1), A, brow + HALF, nt - 1);
    BAR; WAIT_L(0); MMA(0, 0, At, B0); BAR;
    LDB(B1, 0, 1); BAR; WAIT_L(0); MMA(0, 1, At, B1); BAR;
    LDA(At, 0, 1); WAIT_V(4); BAR; WAIT_L(0); MMA(1, 0, At, B0); MMA(1, 1, At, B1); BAR; }
  { LDB(B0, 1, 0); LDA(At, 1, 0); WAIT_V(2); BAR; WAIT_L(0); MMA(0, 0, At, B0); BAR;
    LDB(B1, 1, 1); WAIT_V(0); BAR; WAIT_L(0); MMA(0, 1, At, B1); BAR;
    LDA(At, 1, 1); BAR; WAIT_L(0); MMA(1, 0, At, B0); MMA(1, 1, At, B1); BAR; }
  if (wr == 0) BAR;
  if (has_next) {
    STAGE(SB(0, 0), Bt, nbcol, 0); STAGE(SA(0, 0), A, nbrow, 0);
    STAGE(SB(0, 1), Bt, nbcol + HALF, 0); STAGE(SA(0, 1), A, nbrow + HALF, 0);
    STAGE(SB(1, 0), Bt, nbcol, 1); STAGE(SA(1, 0), A, nbrow, 1); STAGE(SB(1, 1), Bt, nbcol + HALF, 1);
  }
  { int t2 = opaque_tid(epi.p);
    int w2 = t2 >> 6, l2 = t2 & 63;
    epi(acc, brow, bcol, w2 >> 2, w2 & 3, l2 & 15, l2 >> 4); }
  WAIT_L(0); BAR;
#undef SA
#undef SB
}

template <class Epi>
__device__ __forceinline__ void gemm_phase(const u16* A, const u16* Bt, int K, int nN, Epi epi) {
  {
    int x = epi.p.vx, j = epi.p.vj;
    int li = j;
    int mg = li / (nN * 8), rem = li % (nN * 8);
    int brow = (x * 32 + mg * 8 + (rem & 7)) * 256, bcol = (rem >> 3) * 256;
    for (int rd = 0; rd < nN; ++rd) {
      int nbrow = 0, nbcol = 0;
      bool has_next = rd + 1 < nN;
      if (has_next) {
        int l2 = (rd + 1) * 32 + j;
        int mg2 = l2 / (nN * 8), rem2 = l2 % (nN * 8);
        nbrow = (x * 32 + mg2 * 8 + (rem2 & 7)) * 256; nbcol = (rem2 >> 3) * 256;
      }
      gemm_tile(A, Bt, K, brow, bcol, rd == 0, has_next, nbrow, nbcol, epi);
      brow = nbrow; bcol = nbcol;
    }
  }
}

template <class Src>
__device__ __forceinline__ void wt_tile(u16* dst, int ldk, int n0, int k0, Src src, float* tile, int t) {
  int nl = t & 63, kb = t >> 6;
#pragma unroll
  for (int i = 0; i < 8; ++i) {
    int kl = kb + 8 * i;
    tile[kl * 65 + nl] = src(k0 + kl, n0 + nl);
  }
  __syncthreads();
#pragma unroll
  for (int i = 0; i < 8; ++i) {
    int n = kb + 8 * i;
    dst[(size_t)(n0 + n) * ldk + k0 + nl] = f2bf(tile[nl * 65 + n]);
  }
  __syncthreads();
}

__device__ void phase_prep(const P& p) {
  extern __shared__ __attribute__((aligned(16))) u16 shm[];
  float* tile = (float*)shm;
  int tid = opaque_tid(p), lane = tid & 63, wid = tid >> 6;
  u16* xb = (u16*)(p.ws + OFF_XB);
  float* rs1 = (float*)(p.ws + OFF_RS1);
  for (int row = (blockIdx.x * 8 + wid) * 2; row < NTOK; row += gridDim.x * 16) {
    const float4* src0 = (const float4*)xrow(p, row);
    const float4* src1 = (const float4*)xrow(p, row + 1);
    float4 v0[4], v1[4];
#pragma unroll
    for (int i = 0; i < 4; ++i) { v0[i] = src0[lane + i * 64]; v1[i] = src1[lane + i * 64]; }
    float ss0 = 0.f, ss1 = 0.f;
    uint2* dst0 = (uint2*)(xb + (size_t)row * 1024);
    uint2* dst1 = (uint2*)(xb + (size_t)(row + 1) * 1024);
#pragma unroll
    for (int i = 0; i < 4; ++i) {
      ss0 += v0[i].x * v0[i].x + v0[i].y * v0[i].y + v0[i].z * v0[i].z + v0[i].w * v0[i].w;
      ss1 += v1[i].x * v1[i].x + v1[i].y * v1[i].y + v1[i].z * v1[i].z + v1[i].w * v1[i].w;
      uint2 o; o.x = pack2(v0[i].x, v0[i].y); o.y = pack2(v0[i].z, v0[i].w); dst0[lane + i * 64] = o;
      o.x = pack2(v1[i].x, v1[i].y); o.y = pack2(v1[i].z, v1[i].w); dst1[lane + i * 64] = o;
    }
#pragma unroll
    for (int s2 = 32; s2 >= 1; s2 >>= 1) { ss0 += __shfl_xor(ss0, s2); ss1 += __shfl_xor(ss1, s2); }
    if (lane == 0) { rs1[row] = rsqrtf(ss0 * (1.f / 1024.f) + 1e-6f); rs1[row + 1] = rsqrtf(ss1 * (1.f / 1024.f) + 1e-6f); }
  }
  u16* win = (u16*)(p.ws + OFF_WIN);
  u16* wout = (u16*)(p.ws + OFF_WOUT);
  u16* wgu = (u16*)(p.ws + OFF_WGU);
  u16* wdn = (u16*)(p.ws + OFF_WDN);
  const int J0 = 768, J1 = J0 + 64, J2 = J1 + 256, J3 = J2 + 1408, J4 = J3 + 704;
  for (int it = blockIdx.x; it < J4; it += gridDim.x) {
    if (it < J0) {
      int n0 = (it >> 4) * 64, k0 = (it & 15) * 64;
      wt_tile(win, 1024, n0, k0, [&](int k, int n) { return p.w_in[(size_t)k * 3104 + n] * p.g_mix[k]; }, tile, tid);
    } else if (it < J1) {
      int q = it - J0; int n0 = (q >> 4) * 64, k0 = (q & 15) * 64;
      wt_tile(win + (size_t)3072 * 1024, 1024, n0, k0, [&](int k, int n) {
        return n < 32 ? p.w_in[(size_t)k * 3104 + 3072 + n] * p.g_mix[k] : 0.f; }, tile, tid);
    } else if (it < J2) {
      int q = it - J1; int n0 = (q >> 4) * 64, k0 = (q & 15) * 64;
      wt_tile(wout, 1024, n0, k0, [&](int k, int n) { return p.w_out[(size_t)k * 1024 + n]; }, tile, tid);
    } else if (it < J3) {
      int q = it - J2; int n0 = (q >> 4) * 64, k0 = (q & 15) * 64;
      wt_tile(wgu, 1024, n0, k0, [&](int k, int n) {
        int t = n >> 8, w = n & 255; int ff = t * 128 + (w & 127);
        const float* W = (w < 128) ? p.w_fg : p.w_fu;
        return W[(size_t)k * 2816 + ff] * p.g_ffn[k]; }, tile, tid);
    } else {
      int q = it - J3; int n0 = (q / 44) * 64, k0 = (q % 44) * 64;
      wt_tile(wdn, 2816, n0, k0, [&](int k, int n) { return p.w_fd[(size_t)k * 1024 + n]; }, tile, tid);
    }
  }
  if (blockIdx.x == 0 && tid < 256) ((unsigned*)(p.ws + OFF_CNT))[tid] = 0u;
#if FUSE_FINAL
  { uint4* g4 = (uint4*)(p.ws + OFF_SSQ2);
    for (int i = blockIdx.x * 512 + tid; i < (2 << 20) / 16; i += gridDim.x * 512) g4[i] = make_uint4(0u, 0u, 0u, 0u); }
#endif
  { u16* wgt = (u16*)(p.ws + OFF_WGT);
    for (int idx = blockIdx.x * 512 + tid; idx < 8192; idx += gridDim.x * 512) {
      int dir = idx >> 12, col = (idx >> 4) & 255, r = idx & 15;
      wgt[idx] = f2bf((dir ? p.wgb : p.wgf)[r * 256 + col]);
    } }
  float* rope = (float*)(p.ws + OFF_ROPE);
  for (int idx = blockIdx.x * 512 + tid; idx < 8192 * 8; idx += gridDim.x * 512) {
    int pos = idx >> 3, i = idx & 7;
    float inv = exp2f(-((float)i * 0.125f) * log2f(500000.f));
    float ang = (float)pos * inv;
    double a = (double)ang;
    double rr = a - 6.283185307179586 * rint(a * 0.15915494309189535);
    float rf = (float)rr;
    rope[idx * 2] = cosf(rf);
    rope[idx * 2 + 1] = sinf(rf);
  }
}

struct EpiIn {
  P p;
  __device__ __forceinline__ void operator()(f32x4 (&acc)[2][2][4][2], int brow, int bcol, int wr, int wc, int fr, int fq) const {
    const float* rs1 = (const float*)(p.ws + OFF_RS1);
    int nt = bcol >> 8;
    char* outb = (char*)p.out;
    float4 rsq[2][4];
#pragma unroll
    for (int ai = 0; ai < 2; ++ai)
#pragma unroll
      for (int m = 0; m < 4; ++m) rsq[ai][m] = *(const float4*)(rs1 + brow + ai * 128 + wr * 64 + m * 16 + fq * 4);
    __builtin_amdgcn_sched_barrier(0);
    if (nt < 4) {
      u16* dst = (u16*)(outb + (nt < 2 ? OUT_QD : OUT_KD));
      float sc = nt < 2 ? 0.125f * 1.4426950408889634f : 1.f;
      int cbase = (nt & 1) * 256;
      const float2* rope = (const float2*)(p.ws + OFF_ROPE);
      int posmask = brow < NT_P ? 4095 : 8191;
      bool rot = (wc & 1) == 0;
      float2 csc[4], csn[4];
#pragma unroll
      for (int j = 0; j < 4; ++j) csc[j] = rope[((brow + wr * 64 + fq * 4 + j) & posmask) * 8 + (fr & 7)];
#pragma unroll
      for (int ch = 0; ch < 8; ++ch) {
        const int ai = ch >> 2, m = ch & 3;
        int row0 = brow + ai * 128 + wr * 64 + m * 16 + fq * 4;
        if (ch + 1 < 8) {
          int rown = brow + ((ch + 1) >> 2) * 128 + wr * 64 + ((ch + 1) & 3) * 16 + fq * 4;
#pragma unroll
          for (int j = 0; j < 4; ++j) csn[j] = rope[((rown + j) & posmask) * 8 + (fr & 7)];
        }
        __builtin_amdgcn_sched_barrier(0);
        float4 r4 = rsq[ai][m];
        float rr[4] = {r4.x * sc, r4.y * sc, r4.z * sc, r4.w * sc};
        float va[2][4], vb[2][4];
#pragma unroll
        for (int j = 0; j < 4; ++j) {
          float2 cs = csc[j];
#pragma unroll
          for (int bj = 0; bj < 2; ++bj) {
            float v = acc[ai][bj][m][0][j];
            float pr = dpp_f<0x128>(v);
            float sg = (fr < 8) ? -pr : pr;
            float vr = v * cs.x + sg * cs.y;
            v = rot ? vr : v;
            va[bj][j] = v * rr[j];
            vb[bj][j] = acc[ai][bj][m][1][j] * rr[j];
          }
        }
#pragma unroll
        for (int bj = 0; bj < 2; ++bj) {
          int c = cbase + bj * 128 + wc * 32 + fr;
          store_rm4(dst, 512, row0, c, va[bj][0], va[bj][1], va[bj][2], va[bj][3], fr & 1);
          store_rm4(dst, 512, row0, c + 16, vb[bj][0], vb[bj][1], vb[bj][2], vb[bj][3], fr & 1);
        }
        __builtin_amdgcn_sched_barrier(0);
#pragma unroll
        for (int j = 0; j < 4; ++j) csc[j] = csn[j];
      }
    } else if (nt < 6) {
      u16* dst = (u16*)(p.ws + OFF_VDT);
      int L, seq0;
      if (brow < NT_P) { L = 4096; seq0 = brow & ~4095; } else { L = 8192; seq0 = NT_P + ((brow - NT_P) & ~8191); }
      int L16 = L >> 4;
      int cbase = (nt & 1) * 256;
#pragma unroll
      for (int ai = 0; ai < 2; ++ai) {
        int pos0 = brow - seq0 + ai * 128 + wr * 64;
        int idx16 = pos0 >> 4;
        float4 r4[4];
#pragma unroll
        for (int m = 0; m < 4; ++m) r4[m] = rsq[ai][m];
#pragma unroll
        for (int bj = 0; bj < 2; ++bj) {
#pragma unroll
          for (int n = 0; n < 2; ++n) {
            int c = cbase + bj * 128 + wc * 32 + n * 16 + fr;
            int h = c >> 6, d = c & 63;
            u16* dcol = dst + (size_t)seq0 * 512 + ((size_t)(h * 16 + fq * 4) * (L16 >> 2) + (idx16 >> 2)) * 256 + d * 4;
#pragma unroll
            for (int j = 0; j < 4; ++j) {
              uint2 o;
              float a0 = acc[ai][bj][0][n][j] * (j == 0 ? r4[0].x : j == 1 ? r4[0].y : j == 2 ? r4[0].z : r4[0].w);
              float a1 = acc[ai][bj][1][n][j] * (j == 0 ? r4[1].x : j == 1 ? r4[1].y : j == 2 ? r4[1].z : r4[1].w);
              float a2 = acc[ai][bj][2][n][j] * (j == 0 ? r4[2].x : j == 1 ? r4[2].y : j == 2 ? r4[2].z : r4[2].w);
              float a3 = acc[ai][bj][3][n][j] * (j == 0 ? r4[3].x : j == 1 ? r4[3].y : j == 2 ? r4[3].z : r4[3].w);
              o.x = pack2(a0, a1); o.y = pack2(a2, a3);
              *(uint2*)(dcol + (size_t)j * 64 * L16) = o;
            }
          }
          __builtin_amdgcn_sched_barrier(0);
        }
      }
    } else if (nt < 8) {
      u16* dst = (u16*)(p.ws + (nt == 6 ? OFF_QA : OFF_KA));
      float sc = nt == 6 ? 0.125f : 1.f;
#pragma unroll
      for (int ai = 0; ai < 2; ++ai)
#pragma unroll
        for (int m = 0; m < 4; ++m) {
          int row0 = brow + ai * 128 + wr * 64 + m * 16 + fq * 4;
          float4 r4 = rsq[ai][m];
          float rr[4] = {r4.x * sc, r4.y * sc, r4.z * sc, r4.w * sc};
#pragma unroll
          for (int bj = 0; bj < 2; ++bj)
#pragma unroll
            for (int n = 0; n < 2; ++n) {
              int c = bj * 128 + wc * 32 + n * 16 + fr;
              store_rm4(dst, 256, row0, c, acc[ai][bj][m][n][0] * rr[0], acc[ai][bj][m][n][1] * rr[1],
                        acc[ai][bj][m][n][2] * rr[2], acc[ai][bj][m][n][3] * rr[3], fr & 1);
            }
          __builtin_amdgcn_sched_barrier(0);
        }
    } else if (nt < 10) {
      u16* dst = (u16*)(p.ws + OFF_VAT);
      int cbase = (nt & 1) * 256;
#pragma unroll
      for (int ai = 0; ai < 2; ++ai) {
        int chunk = (brow + ai * 128 + wr * 64) >> 6;
#pragma unroll
        for (int m = 0; m < 4; ++m) {
          float4 r4 = rsq[ai][m];
#pragma unroll
          for (int bj = 0; bj < 2; ++bj)
#pragma unroll
            for (int n = 0; n < 2; ++n) {
              int c = cbase + bj * 128 + wc * 32 + n * 16 + fr;
              int h = c >> 7, dv = c & 127;
              uint2 o;
              o.x = pack2(acc[ai][bj][m][n][0] * r4.x, acc[ai][bj][m][n][1] * r4.y);
              o.y = pack2(acc[ai][bj][m][n][2] * r4.z, acc[ai][bj][m][n][3] * r4.w);
              *(uint2*)(dst + ((size_t)(chunk * 4 + h) * 128 + dv) * 64 + m * 16 + fq * 4) = o;
            }
          __builtin_amdgcn_sched_barrier(0);
        }
      }
    } else if (nt < 12) {
      u16* dst = (u16*)(p.ws + OFF_RA);
      int cbase = (nt & 1) * 256;
#pragma unroll
      for (int ai = 0; ai < 2; ++ai) {
        int chunk = (brow + ai * 128 + wr * 64) >> 6;
#pragma unroll
        for (int m = 0; m < 4; ++m) {
          float4 r4 = rsq[ai][m];
#pragma unroll
          for (int bj = 0; bj < 2; ++bj)
#pragma unroll
            for (int n = 0; n < 2; ++n) {
              int c = cbase + bj * 128 + wc * 32 + n * 16 + fr;
              int h = c >> 7, dv = c & 127;
              uint2 o;
              o.x = pack2(fast_silu(acc[ai][bj][m][n][0] * r4.x), fast_silu(acc[ai][bj][m][n][1] * r4.y));
              o.y = pack2(fast_silu(acc[ai][bj][m][n][2] * r4.z), fast_silu(acc[ai][bj][m][n][3] * r4.w));
              *(uint2*)(dst + ((size_t)(chunk * 4 + h) * 128 + dv) * 64 + m * 16 + fq * 4) = o;
            }
          __builtin_amdgcn_sched_barrier(0);
        }
      }
    } else {
      extern __shared__ __attribute__((aligned(16))) u16 shm[];
      u16* glr = (u16*)((char*)shm + 3 * HT * 2);
      if (wc == 0) {
#pragma unroll
        for (int ai = 0; ai < 2; ++ai)
#pragma unroll
          for (int m = 0; m < 4; ++m) {
            int rl0 = ai * 128 + wr * 64 + m * 16 + fq * 4;
            float4 r4 = rsq[ai][m];
            float rr[4] = {r4.x, r4.y, r4.z, r4.w};
#pragma unroll
            for (int n = 0; n < 2; ++n)
#pragma unroll
              for (int j = 0; j < 4; ++j) glr[(rl0 + j) * 32 + n * 16 + fr] = f2bf(acc[ai][0][m][n][j] * rr[j]);
          }
      }
      __syncthreads();
      typedef short s16x4 __attribute__((ext_vector_type(4)));
      const u16* wgt = (const u16*)(p.ws + OFF_WGT);
#pragma unroll
      for (int dir = 0; dir < 2; ++dir) {
        s16x4 bfr[2][2];
#pragma unroll
        for (int bj = 0; bj < 2; ++bj)
#pragma unroll
          for (int n = 0; n < 2; ++n)
            bfr[bj][n] = *(const s16x4*)(wgt + ((size_t)(dir * 256 + bj * 128 + wc * 32 + n * 16 + fr)) * 16 + fq * 4);
        u16* dst = (u16*)(p.ws + (dir == 0 ? OFF_LAF : OFF_LAB));
        const float* bias = dir == 0 ? p.bgf : p.bgb;
#pragma unroll
        for (int ai = 0; ai < 2; ++ai)
#pragma unroll
          for (int m = 0; m < 4; ++m) {
            int rl = ai * 128 + wr * 64 + m * 16;
            s16x4 af = *(const s16x4*)(glr + (rl + fr) * 32 + dir * 16 + fq * 4);
            int row0 = brow + rl + fq * 4;
#pragma unroll
            for (int bj = 0; bj < 2; ++bj)
#pragma unroll
              for (int n = 0; n < 2; ++n) {
                f32x4 z4 = {0.f, 0.f, 0.f, 0.f};
                z4 = __builtin_amdgcn_mfma_f32_16x16x16bf16_1k(af, bfr[bj][n], z4, 0, 0, 0);
                int c = bj * 128 + wc * 32 + n * 16 + fr;
                float bb = bias[c];
                float ls[4];
#pragma unroll
                for (int j = 0; j < 4; ++j) {
                  float z = z4[j] + bb;
                  ls[j] = (fminf(z, 0.f) - __logf(1.f + __expf(-fabsf(z)))) * (1.f / 16.f);
                }
                store_rm4(dst, 256, row0, c, ls[0], ls[1], ls[2], ls[3], fr & 1);
              }
            __builtin_amdgcn_sched_barrier(0);
          }
      }
    }
  }
};

typedef bf16x8 __attribute__((aligned(8))) bf16x8_a8;
struct KVB { bf16x8 k0, k1, k2, k3; bf16x8 v0, v1, v2, v3; };
constexpr int ATT_NKS = 23;

__device__ __forceinline__ void attn_desc(int ks, int g, int r, int i0, int& c, int& s) {
  if (ks < 12) { c = 4 * (ks & 3) + g; s = i0 - 4 + 8 * (ks >> 2); }
  else if (ks < 18) { c = (r & 3) + 4 * g; s = i0 - 16 + 8 * (ks - 12); }
  else { c = r; s = i0 - 64 + 8 * ((ks - 18) * 4 + g); }
}

__device__ __forceinline__ KVB attn_load(int ks, const u16* __restrict__ kbase, const u16* __restrict__ vbase, int L16,
                                         int r, int i0, int lane) {
  KVB b;
  const int quad = lane >> 4, l15 = lane & 15, gk = l15 >> 2, ek = l15 & 3;
  int cK, sK; attn_desc(ks, gk, r, i0, cK, sK);
  int ia = sK + ek, ib = ia + 4;
  ia = min(max(ia, 0), L16 - 1); ib = min(max(ib, 0), L16 - 1);
  const u16* ka = kbase + (size_t)(cK + 16 * ia) * 512;
  const u16* kb = kbase + (size_t)(cK + 16 * ib) * 512;
  b.k0 = *(const bf16x8*)ka; b.k1 = *(const bf16x8*)(ka + 8);
  b.k2 = *(const bf16x8*)kb; b.k3 = *(const bf16x8*)(kb + 8);
  int cV, sV; attn_desc(ks, quad, r, i0, cV, sV);
  const u16* vp = vbase + ((ptrdiff_t)cV * (L16 >> 2) + (sV >> 2)) * 256 + l15 * 4;
  {
    union { struct { uint2 a, b; } p; bf16x8 v; } c0, c1, c2, c3;
    c0.p.a = *(const uint2*)(vp);        c0.p.b = *(const uint2*)(vp + 256);
    c1.p.a = *(const uint2*)(vp + 64);   c1.p.b = *(const uint2*)(vp + 64 + 256);
    c2.p.a = *(const uint2*)(vp + 128);  c2.p.b = *(const uint2*)(vp + 128 + 256);
    c3.p.a = *(const uint2*)(vp + 192);  c3.p.b = *(const uint2*)(vp + 192 + 256);
    b.v0 = c0.v; b.v1 = c1.v; b.v2 = c2.v; b.v3 = c3.v;
  }
  return b;
}

__device__ __forceinline__ void attn_step(int ks, const KVB& b, int L16, int r, int i0, int iq, int lane,
                                          const bf16x8* qs, f32x4 (&o)[4], float& mrun, float& lrun) {
  asm volatile("" : "+v"(lane), "+v"(iq));
  asm volatile("" : "+s"(r), "+s"(i0));
  const int quad = lane >> 4;
  bf16x8 qB0 = qs[0], qB1 = qs[64];
  int cV, sV; attn_desc(ks, quad, r, i0, cV, sV);
  int D = ks < 12 ? 4 : (ks < 18 ? 16 : 64);
  f32x4 z = {0.f, 0.f, 0.f, 0.f};
  f32x4 sa = __builtin_amdgcn_mfma_f32_16x16x32_bf16(b.k0, qB0, z, 0, 0, 0);
  sa = __builtin_amdgcn_mfma_f32_16x16x32_bf16(b.k1, qB1, sa, 0, 0, 0);
  f32x4 sb = __builtin_amdgcn_mfma_f32_16x16x32_bf16(b.k2, qB0, z, 0, 0, 0);
  sb = __builtin_amdgcn_mfma_f32_16x16x32_bf16(b.k3, qB1, sb, 0, 0, 0);
  int jlo = max(iq - D + (cV < r ? 1 : 0), 0) - sV;
  int jhi = min(iq + D - (cV > r ? 1 : 0), L16 - 1) - sV;
  const float NINF = -__builtin_inff();
  float s8[8];
  float mt = -1e30f;
#pragma unroll
  for (int j = 0; j < 8; ++j) {
    float sv = j < 4 ? sa[j] : sb[j - 4];
    sv = (j >= jlo && j <= jhi) ? sv : NINF;
    s8[j] = sv;
    mt = fmaxf(mt, sv);
  }
  mt = fmaxf(mt, __shfl_xor(mt, 16));
  mt = fmaxf(mt, __shfl_xor(mt, 32));
  float mnew = fmaxf(mrun, mt);
  float alpha = __builtin_amdgcn_exp2f(mrun - mnew);
  bool grew = mnew > mrun;
  mrun = mnew;
  float ps = 0.f;
  float p8[8];
#pragma unroll
  for (int j = 0; j < 8; ++j) { p8[j] = __builtin_amdgcn_exp2f(s8[j] - mnew); ps += p8[j]; }
  lrun = lrun * alpha + ps;
  union { uint4 u; bf16x8 v; } pb;
  pb.u = make_uint4(pack2(p8[0], p8[1]), pack2(p8[2], p8[3]), pack2(p8[4], p8[5]), pack2(p8[6], p8[7]));
  if (__builtin_amdgcn_ballot_w64(grew) != 0) {
#pragma unroll
    for (int dt = 0; dt < 4; ++dt) { o[dt][0] *= alpha; o[dt][1] *= alpha; o[dt][2] *= alpha; o[dt][3] *= alpha; }
  }
  o[0] = __builtin_amdgcn_mfma_f32_16x16x32_bf16(b.v0, pb.v, o[0], 0, 0, 0);
  o[1] = __builtin_amdgcn_mfma_f32_16x16x32_bf16(b.v1, pb.v, o[1], 0, 0, 0);
  o[2] = __builtin_amdgcn_mfma_f32_16x16x32_bf16(b.v2, pb.v, o[2], 0, 0, 0);
  o[3] = __builtin_amdgcn_mfma_f32_16x16x32_bf16(b.v3, pb.v, o[3], 0, 0, 0);
}

template <int NT>
__device__ __forceinline__ KVB attn_load_e(int e, const u16* kbase, const u16* vbase, int L16, int rb, int i0, int lane) {
  int ks, r;
  if (e < 18) { ks = e; r = rb; } else { int f = e - 18; ks = 18 + f / NT; r = rb + (16 / NT) * (f % NT); }
  return attn_load(ks, kbase, vbase, L16, r, i0, lane);
}

template <int NT>
__device__ void attn_unitN(const P& p, int u) {
  constexpr int RS = 16 / NT;
  constexpr int EMAX = 18 + 5 * NT - 1;
  int lane = opaque_tid(p) & 63, q = lane & 15, quad = lane >> 4;
  int rb = u % RS, h = (u / RS) & 7, span = u / (RS * 8);
  int tb = span * 256;
  int seq0, L;
  if (tb < NT_P) { L = 4096; seq0 = tb & ~4095; } else { L = 8192; seq0 = NT_P + ((tb - NT_P) & ~8191); }
  int L16 = L >> 4;
  int i0 = (tb - seq0) >> 4;
  int iq = i0 + q;
  const u16* Qd = (const u16*)((const char*)p.out + OUT_QD);
  const u16* Kd = (const u16*)((const char*)p.out + OUT_KD);
  const u16* VdT = (const u16*)(p.ws + OFF_VDT);
  extern __shared__ __attribute__((aligned(16))) u16 shm[];
  bf16x8* qs = (bf16x8*)((char*)shm + __builtin_amdgcn_readfirstlane(opaque_tid(p) >> 6) * 8192) + lane;
  f32x4 o[NT][4];
  float mrun[NT], lrun[NT];
#pragma unroll
  for (int t = 0; t < NT; ++t) {
    const u16* qp = Qd + (size_t)(seq0 + rb + RS * t + 16 * iq) * 512 + h * 64 + quad * 16;
    qs[t * 128] = *(const bf16x8*)qp; qs[t * 128 + 64] = *(const bf16x8*)(qp + 8);
#pragma unroll
    for (int dt = 0; dt < 4; ++dt) o[t][dt] = f32x4{0.f, 0.f, 0.f, 0.f};
    mrun[t] = -1e30f; lrun[t] = 0.f;
  }
  const u16* kbase = Kd + (size_t)seq0 * 512 + h * 64 + quad * 16;
  const u16* vbase = VdT + (size_t)seq0 * 512 + (size_t)h * 16 * 64 * L16;
  KVB bA = attn_load_e<NT>(0, kbase, vbase, L16, rb, i0, lane);
  KVB bB = attn_load_e<NT>(1, kbase, vbase, L16, rb, i0, lane);
#pragma unroll 1
  for (int ks = 0; ks < 18; ks += 2) {
#pragma unroll
    for (int t = 0; t < NT; ++t)
      attn_step(ks, bA, L16, rb + RS * t, i0, iq, lane, qs + t * 128, o[t], mrun[t], lrun[t]);
    bA = attn_load_e<NT>(ks + 2, kbase, vbase, L16, rb, i0, lane);
#pragma unroll
    for (int t = 0; t < NT; ++t)
      attn_step(ks + 1, bB, L16, rb + RS * t, i0, iq, lane, qs + t * 128, o[t], mrun[t], lrun[t]);
    bB = attn_load_e<NT>(ks + 3, kbase, vbase, L16, rb, i0, lane);
  }
#pragma unroll 1
  for (int kk = 0; kk < 5; ++kk) {
    int e0 = 18 + NT * kk, ks = 18 + kk;
#pragma unroll
    for (int t = 0; t < NT; t += 2) {
      attn_step(ks, bA, L16, rb + RS * t, i0, iq, lane, qs + t * 128, o[t], mrun[t], lrun[t]);
      bA = attn_load_e<NT>(min(e0 + t + 2, EMAX), kbase, vbase, L16, rb, i0, lane);
      attn_step(ks, bB, L16, rb + RS * (t + 1), i0, iq, lane, qs + (t + 1) * 128, o[t + 1], mrun[t + 1], lrun[t + 1]);
      bB = attn_load_e<NT>(min(e0 + t + 3, EMAX), kbase, vbase, L16, rb, i0, lane);
    }
  }
  u16* omix = (u16*)(p.ws + OFF_OMIX);
#pragma unroll
  for (int t = 0; t < NT; ++t) {
    float l = lrun[t];
    l += __shfl_xor(l, 16);
    l += __shfl_xor(l, 32);
    float inv = 1.f / l;
    u16* op = omix + (size_t)(seq0 + rb + RS * t + 16 * iq) * 1024 + h * 64 + quad * 4;
#pragma unroll
    for (int dt = 0; dt < 4; ++dt) {
      uint2 w; w.x = pack2(o[t][dt][0] * inv, o[t][dt][1] * inv); w.y = pack2(o[t][dt][2] * inv, o[t][dt][3] * inv);
      *(uint2*)(op + dt * 16) = w;
    }
  }
}

constexpr int ATT_NT = 4;
__device__ void phase_attn(const P& p) {
  int wid = __builtin_amdgcn_readfirstlane(opaque_tid(p) >> 6);
  for (int u = blockIdx.x * 8 + wid; u < 32768 / ATT_NT; u += gridDim.x * 8) attn_unitN<ATT_NT>(p, u);
}

constexpr int LP = 72;
constexpr int G_BF = 0;
constexpr int G_BB = G_BF + 64 * 65 * 4;
constexpr int G_T0 = G_BB + 64 * 65 * 4;
constexpr int G_T1 = G_T0 + 64 * LP * 2;
constexpr int G_T2 = G_T1 + 64 * LP * 2;
constexpr int G_T3 = G_T2 + 64 * LP * 2;
constexpr int G_VT = G_T3 + 64 * LP * 2;
constexpr int G_ATT = G_VT + 128 * LP * 2;
constexpr int G_SSQ = G_ATT + 64 * LP * 2;
constexpr int G_SEG = G_SSQ + 512;

#define LBAR do { asm volatile("s_waitcnt lgkmcnt(0)" ::: "memory"); __builtin_amdgcn_s_barrier(); } while (0)
__device__ __forceinline__ void gla_cumsum(const P& p, uint4 a, uint4 b, char* sm) {
  float* bF = (float*)(sm + G_BF);
  float* bB = (float*)(sm + G_BB);
  int tid = opaque_tid(p);
  {
    int s = tid >> 3, d0 = (tid & 7) * 8;
    const u16* pa = (const u16*)&a; const u16* pb = (const u16*)&b;
#pragma unroll
    for (int e = 0; e < 8; ++e) { bF[s * 65 + d0 + e] = bf2f(pa[e]); bB[s * 65 + d0 + e] = bf2f(pb[e]); }
  }
  LBAR;
  {
    float* segF = (float*)(sm + G_SEG);
    float* segB = segF + 8 * 64;
    int dk = tid & 63, seg = tid >> 6;
    float a = 0.f, c = 0.f;
#pragma unroll
    for (int i = 0; i < 8; ++i) { a += bF[(seg * 8 + i) * 65 + dk]; bF[(seg * 8 + i) * 65 + dk] = a; }
#pragma unroll
    for (int i = 7; i >= 0; --i) { c += bB[(seg * 8 + i) * 65 + dk]; bB[(seg * 8 + i) * 65 + dk] = c; }
    segF[seg * 64 + dk] = a; segB[seg * 64 + dk] = c;
    LBAR;
    float offF = 0.f, offB = 0.f;
#pragma unroll
    for (int s2 = 0; s2 < 8; ++s2) {
      float f = segF[s2 * 64 + dk], g = segB[s2 * 64 + dk];
      offF += (s2 < seg) ? f : 0.f;
      offB += (s2 > seg) ? g : 0.f;
    }
#pragma unroll
    for (int i = 0; i < 8; ++i) { bF[(seg * 8 + i) * 65 + dk] += offF; bB[(seg * 8 + i) * 65 + dk] += offB; }
  }
  LBAR;
}

struct SummRaw { uint4 laf, lab, k, v0, v1; };
__device__ __forceinline__ SummRaw gla_summ_load(const P& p, int unit, int tid) {
  SummRaw r;
  int chunk = unit >> 2, h = unit & 3;
  { int s = tid >> 3, d0 = (tid & 7) * 8;
    size_t g = (size_t)(chunk * 64 + s) * 256 + h * 64 + d0;
    r.laf = *(const uint4*)((const u16*)(p.ws + OFF_LAF) + g);
    r.lab = *(const uint4*)((const u16*)(p.ws + OFF_LAB) + g); }
  { int s = tid & 63, dg = tid >> 6;
    r.k = *(const uint4*)((const u16*)(p.ws + OFF_KA) + (size_t)(chunk * 64 + s) * 256 + h * 64 + dg * 8); }
  const u16* vsrc = (const u16*)(p.ws + OFF_VAT) + (size_t)unit * 8192;
  r.v0 = *(const uint4*)(vsrc + (tid >> 3) * 64 + (tid & 7) * 8);
  r.v1 = *(const uint4*)(vsrc + ((tid + 512) >> 3) * 64 + (tid & 7) * 8);
  return r;
}

__device__ __forceinline__ void gla_summ_unit(const P& p, int unit, const SummRaw& raw) {
  extern __shared__ __attribute__((aligned(16))) u16 shm[];
  char* sm = (char*)shm;
  int tid = opaque_tid(p), lane = tid & 63, wid = tid >> 6;
  gla_cumsum(p, raw.laf, raw.lab, sm);
  float* bF = (float*)(sm + G_BF);
  float* bB = (float*)(sm + G_BB);
  u16* kdfT = (u16*)(sm + G_T0);
  u16* kdbT = (u16*)(sm + G_T1);
  u16* vT = (u16*)(sm + G_VT);
  {
    int s = tid & 63, dg = tid >> 6;
    const u16* pk = (const u16*)&raw.k;
#pragma unroll
    for (int e = 0; e < 8; ++e) {
      int dk = dg * 8 + e;
      float k = bf2f(pk[e]);
      kdfT[dk * LP + s] = f2bf(k * __expf(bF[63 * 65 + dk] - bF[s * 65 + dk]));
      kdbT[dk * LP + s] = f2bf(k * __expf(bB[0 * 65 + dk] - bB[s * 65 + dk]));
    }
    *(uint4*)(vT + (tid >> 3) * LP + (tid & 7) * 8) = raw.v0;
    *(uint4*)(vT + ((tid + 512) >> 3) * LP + (tid & 7) * 8) = raw.v1;
    if (tid < 128) {
      int dir = tid >> 6, dk = tid & 63;
      float* dec = (float*)(p.ws + OFF_DEC);
      dec[(size_t)(unit * 2 + dir) * 64 + dk] = __expf(dir == 0 ? bF[63 * 65 + dk] : bB[dk]);
    }
  }
  LBAR;
  u16* kvout = (u16*)((char*)p.out + OUT_KV);
  int fr = lane & 15, fq = lane >> 4;
#pragma unroll 1
  for (int tI = 0; tI < 8; ++tI) {
    int tile = wid * 8 + tI;
    int dir = tile >> 5, dkt = (tile >> 3) & 3, dvt = tile & 7;
    const u16* Asrc = (dir ? kdbT : kdfT) + (dkt * 16 + fr) * LP + fq * 8;
    const u16* Bsrc = vT + (dvt * 16 + fr) * LP + fq * 8;
    f32x4 d = {0.f, 0.f, 0.f, 0.f};
#pragma unroll
    for (int ks = 0; ks < 2; ++ks) {
      bf16x8 a = *(const bf16x8*)(Asrc + ks * 32);
      bf16x8 b = *(const bf16x8*)(Bsrc + ks * 32);
      d = __builtin_amdgcn_mfma_f32_16x16x32_bf16(a, b, d, 0, 0, 0);
    }
    uint2 w; w.x = pack2(d[0], d[1]); w.y = pack2(d[2], d[3]);
    *(uint2*)(kvout + (size_t)(unit * 2 + dir) * 8192 + (dvt * 16 + fr) * 64 + dkt * 16 + fq * 4) = w;
  }
  LBAR;
}

__device__ void phase_gla_summ(const P& p) {
  int tid = opaque_tid(p);
  int u = blockIdx.x;
  if (u >= 4096) return;
  SummRaw cur = gla_summ_load(p, u, tid);
  for (; u < 4096; u += gridDim.x) {
    int un = u + gridDim.x;
    SummRaw nxt = gla_summ_load(p, un < 4096 ? un : u, tid);
    gla_summ_unit(p, u, cur);
    cur = nxt;
  }
}

__device__ void phase_gla_scan(const P& p) {
  u16* kv = (u16*)((char*)p.out + OUT_KV);
  const float* dec = (const float*)(p.ws + OFF_DEC);
  int tid = opaque_tid(p);
  for (int it = blockIdx.x; it < 768; it += gridDim.x) {
    int chunk0, nc, q;
    if (it < 256) { q = it; int seq = q >> 6; chunk0 = 512 + seq * 128; nc = 128; q &= 63; }
    else { q = it - 256; int seq = q >> 6; chunk0 = seq * 64; nc = 64; q &= 63; }
    int h = q >> 4, dir = (q >> 3) & 1, sl = q & 7;
    int e0 = sl * 1024 + tid * 2;
    int dk = e0 & 63;
    float s0 = 0.f, s1 = 0.f;
    for (int n8 = 0; n8 < nc; n8 += 8) {
      unsigned kvv[8]; float2 dd[8];
#pragma unroll
      for (int i = 0; i < 8; ++i) {
        int n = n8 + i;
        int chunk = dir == 0 ? chunk0 + n : chunk0 + nc - 1 - n;
        size_t base = (size_t)((chunk * 4 + h) * 2 + dir);
        kvv[i] = *(const unsigned*)(kv + base * 8192 + e0);
        dd[i] = *(const float2*)(dec + base * 64 + dk);
      }
#pragma unroll
      for (int i = 0; i < 8; ++i) {
        int n = n8 + i;
        int chunk = dir == 0 ? chunk0 + n : chunk0 + nc - 1 - n;
        size_t base = (size_t)((chunk * 4 + h) * 2 + dir);
        *(unsigned*)(kv + base * 8192 + e0) = pack2(s0, s1);
        s0 = dd[i].x * s0 + bf2f((u16)(kvv[i] & 0xffff));
        s1 = dd[i].y * s1 + bf2f((u16)(kvv[i] >> 16));
      }
    }
  }
}

struct OutRaw { uint4 laf, lab, q, k, v0, v1; };
__device__ __forceinline__ OutRaw gla_out_load(const P& p, int unit, int tid) {
  OutRaw r;
  int chunk = unit >> 2, h = unit & 3;
  int s = tid >> 3, d0 = (tid & 7) * 8;
  size_t g = (size_t)(chunk * 64 + s) * 256 + h * 64 + d0;
  r.laf = *(const uint4*)((const u16*)(p.ws + OFF_LAF) + g);
  r.lab = *(const uint4*)((const u16*)(p.ws + OFF_LAB) + g);
  r.q = *(const uint4*)((const u16*)(p.ws + OFF_QA) + g);
  r.k = *(const uint4*)((const u16*)(p.ws + OFF_KA) + g);
  const u16* vsrc = (const u16*)(p.ws + OFF_VAT) + (size_t)unit * 8192;
  r.v0 = *(const uint4*)(vsrc + (tid >> 3) * 64 + (tid & 7) * 8);
  r.v1 = *(const uint4*)(vsrc + ((tid + 512) >> 3) * 64 + (tid & 7) * 8);
  return r;
}

__device__ __forceinline__ void gla_out_unit(const P& p, int unit, const OutRaw& raw) {
  extern __shared__ __attribute__((aligned(16))) u16 shm[];
  char* sm = (char*)shm;
  int chunk = unit >> 2, h = unit & 3;
  int tid = opaque_tid(p), lane = tid & 63, wid = tid >> 6;
  bf16x8 sB[4][2][2];
  uint2 rav[4];
  {
    int fr = lane & 15, fq = lane >> 4, tt = wid >> 1, dvh = wid & 1;
    const u16* Sst = (const u16*)((const char*)p.out + OUT_KV) + (size_t)(unit * 2) * 8192;
    const u16* ra = (const u16*)(p.ws + OFF_RA);
#pragma unroll
    for (int i = 0; i < 4; ++i) {
      int dvt = dvh * 4 + i;
#pragma unroll
      for (int ks = 0; ks < 2; ++ks) {
        sB[i][ks][0] = *(const bf16x8*)(Sst + (dvt * 16 + fr) * 64 + ks * 32 + fq * 8);
        sB[i][ks][1] = *(const bf16x8*)(Sst + 8192 + (dvt * 16 + fr) * 64 + ks * 32 + fq * 8);
      }
      rav[i] = *(const uint2*)(ra + ((size_t)unit * 128 + dvt * 16 + fr) * 64 + tt * 16 + fq * 4);
    }
  }
  gla_cumsum(p, raw.laf, raw.lab, sm);
  float* bF = (float*)(sm + G_BF);
  float* bB = (float*)(sm + G_BB);
  u16* qf = (u16*)(sm + G_T0);
  u16* qb = (u16*)(sm + G_T1);
  u16* kf = (u16*)(sm + G_T2);
  u16* kb = (u16*)(sm + G_T3);
  u16* vT = (u16*)(sm + G_VT);
  u16* att = (u16*)(sm + G_ATT);
  float* ssq = (float*)(sm + G_SSQ);
  {
    int s = tid >> 3, d0 = (tid & 7) * 8;
    const u16* pq = (const u16*)&raw.q; const u16* pk = (const u16*)&raw.k;
    u16 oqf[8], oqb[8], okf[8], okb[8];
#pragma unroll
    for (int e = 0; e < 8; ++e) {
      float bf = bF[s * 65 + d0 + e], bb = bB[s * 65 + d0 + e];
      float qq = bf2f(pq[e]), kk = bf2f(pk[e]);
      oqf[e] = f2bf(qq * __expf(bf)); oqb[e] = f2bf(qq * __expf(bb));
      okf[e] = f2bf(kk * __expf(-bf)); okb[e] = f2bf(kk * __expf(-bb));
    }
    *(uint4*)(qf + s * LP + d0) = *(const uint4*)oqf;
    *(uint4*)(qb + s * LP + d0) = *(const uint4*)oqb;
    *(uint4*)(kf + s * LP + d0) = *(const uint4*)okf;
    *(uint4*)(kb + s * LP + d0) = *(const uint4*)okb;
    *(uint4*)(vT + (tid >> 3) * LP + (tid & 7) * 8) = raw.v0;
    *(uint4*)(vT + ((tid + 512) >> 3) * LP + (tid & 7) * 8) = raw.v1;
  }
  LBAR;
  int fr = lane & 15, fq = lane >> 4;
#pragma unroll 1
  for (int tI = 0; tI < 2; ++tI) {
    int tile = wid * 2 + tI; int tt = tile >> 2, st = tile & 3;
    f32x4 df = {0.f, 0.f, 0.f, 0.f}, db = {0.f, 0.f, 0.f, 0.f};
#pragma unroll
    for (int ks = 0; ks < 2; ++ks) {
      bf16x8 a = *(const bf16x8*)(qf + (tt * 16 + fr) * LP + ks * 32 + fq * 8);
      bf16x8 b = *(const bf16x8*)(kf + (st * 16 + fr) * LP + ks * 32 + fq * 8);
      df = __builtin_amdgcn_mfma_f32_16x16x32_bf16(a, b, df, 0, 0, 0);
      bf16x8 a2 = *(const bf16x8*)(qb + (tt * 16 + fr) * LP + ks * 32 + fq * 8);
      bf16x8 b2 = *(const bf16x8*)(kb + (st * 16 + fr) * LP + ks * 32 + fq * 8);
      db = __builtin_amdgcn_mfma_f32_16x16x32_bf16(a2, b2, db, 0, 0, 0);
    }
    int s = st * 16 + fr;
#pragma unroll
    for (int j = 0; j < 4; ++j) {
      int t = tt * 16 + fq * 4 + j;
      float v = (s <= t) ? df[j] : db[j];
      att[t * LP + s] = f2bf(v);
    }
  }
  LBAR;
  int tt = wid >> 1, dvh = wid & 1;
  f32x4 o[4];
  float sq[4] = {0.f, 0.f, 0.f, 0.f};
#pragma unroll
  for (int i = 0; i < 4; ++i) {
    int dvt = dvh * 4 + i;
    f32x4 d = {0.f, 0.f, 0.f, 0.f};
#pragma unroll
    for (int ks = 0; ks < 2; ++ks) {
      bf16x8 a = *(const bf16x8*)(att + (tt * 16 + fr) * LP + ks * 32 + fq * 8);
      bf16x8 b = *(const bf16x8*)(vT + (dvt * 16 + fr) * LP + ks * 32 + fq * 8);
      d = __builtin_amdgcn_mfma_f32_16x16x32_bf16(a, b, d, 0, 0, 0);
      bf16x8 a1 = *(const bf16x8*)(qf + (tt * 16 + fr) * LP + ks * 32 + fq * 8);
      bf16x8 b1 = sB[i][ks][0];
      d = __builtin_amdgcn_mfma_f32_16x16x32_bf16(a1, b1, d, 0, 0, 0);
      bf16x8 a2 = *(const bf16x8*)(qb + (tt * 16 + fr) * LP + ks * 32 + fq * 8);
      bf16x8 b2 = sB[i][ks][1];
      d = __builtin_amdgcn_mfma_f32_16x16x32_bf16(a2, b2, d, 0, 0, 0);
    }
    o[i] = d;
#pragma unroll
    for (int j = 0; j < 4; ++j) sq[j] += d[j] * d[j];
  }
#pragma unroll
  for (int j = 0; j < 4; ++j) {
    float v = sq[j];
    v = row16_sum(v);
    sq[j] = v;
  }
  if (fr == 0) {
#pragma unroll
    for (int j = 0; j < 4; ++j) ssq[(tt * 16 + fq * 4 + j) * 2 + dvh] = sq[j];
  }
  LBAR;
  u16* omix = (u16*)(p.ws + OFF_OMIX);
  {
    float rsj[4];
#pragma unroll
    for (int j = 0; j < 4; ++j) {
      int t = tt * 16 + fq * 4 + j;
      float tot = ssq[t * 2] + ssq[t * 2 + 1];
      rsj[j] = rsqrtf(tot * (1.f / 128.f) + 1e-6f);
    }
    int row0 = chunk * 64 + tt * 16 + fq * 4;
#pragma unroll
    for (int i = 0; i < 4; ++i) {
      int dv = (dvh * 4 + i) * 16 + fr;
      float g = p.g_gla[dv];
      float s0 = __uint_as_float(rav[i].x << 16), s1 = __uint_as_float(rav[i].x & 0xffff0000u);
      float s2 = __uint_as_float(rav[i].y << 16), s3 = __uint_as_float(rav[i].y & 0xffff0000u);
      store_rm4(omix, 1024, row0, 512 + h * 128 + dv, o[i][0] * rsj[0] * g * s0, o[i][1] * rsj[1] * g * s1,
                o[i][2] * rsj[2] * g * s2, o[i][3] * rsj[3] * g * s3, fr & 1);
    }
  }
  LBAR;
}

__device__ void phase_gla_out(const P& p) {
  int tid = opaque_tid(p);
  int u = blockIdx.x;
  if (u >= 4096) return;
  OutRaw cur = gla_out_load(p, u, tid);
  for (; u < 4096; u += gridDim.x) {
    int un = u + gridDim.x;
    OutRaw nxt = gla_out_load(p, un < 4096 ? un : u, tid);
    gla_out_unit(p, u, cur);
    cur = nxt;
  }
}

__device__ __forceinline__ void ssq_store(float (&sq)[2][4][4], float* dstbase, int brow, int slot, int wr, int fr, int fq) {
#pragma unroll
  for (int ai = 0; ai < 2; ++ai)
#pragma unroll
    for (int m = 0; m < 4; ++m)
#pragma unroll
      for (int j = 0; j < 4; ++j) {
        float v = sq[ai][m][j];
        v = row16_sum(v);
        if (fr == 0) dstbase[(size_t)(brow + ai * 128 + wr * 64 + m * 16 + fq * 4 + j) * 16 + slot] = v;
      }
}

struct EpiOut {
  P p; static constexpr bool twice = false;
  __device__ __forceinline__ void operator()(f32x4 (&acc)[2][2][4][2], int brow, int bcol, int wr, int wc, int fr, int fq) const {
    u16* x1b = (u16*)(p.ws + OFF_X1B);
    float* ssq1 = (float*)(p.ws + OFF_SSQ1);
    int slot = (bcol >> 8) * 4 + wc;
    const bool odd = fr & 1;
    const int o1 = odd ? 1 : 0;
    float2 tc[4][2], tn[4][2];
    {
      const float* xb0 = xrow(p, brow + wr * 64 + fq * 4);
#pragma unroll
      for (int q = 0; q < 4; ++q)
#pragma unroll
        for (int pr = 0; pr < 2; ++pr)
          tc[q][pr] = *(const float2*)(xb0 + (size_t)(2 * pr + o1) * 1024 + (bcol + (q >> 1) * 128 + wc * 32 + (q & 1) * 16 + fr - o1));
    }
#pragma unroll
    for (int ch = 0; ch < 8; ++ch) {
      const int ai = ch >> 2, m = ch & 3;
      int row0 = brow + ai * 128 + wr * 64 + m * 16 + fq * 4;
      if (ch + 1 < 8) {
        const float* xbn = xrow(p, brow + ((ch + 1) >> 2) * 128 + wr * 64 + ((ch + 1) & 3) * 16 + fq * 4);
#pragma unroll
        for (int q = 0; q < 4; ++q)
#pragma unroll
          for (int pr = 0; pr < 2; ++pr)
            tn[q][pr] = *(const float2*)(xbn + (size_t)(2 * pr + o1) * 1024 + (bcol + (q >> 1) * 128 + wc * 32 + (q & 1) * 16 + fr - o1));
      }
      __builtin_amdgcn_sched_barrier(0);
      float sq[4] = {0.f, 0.f, 0.f, 0.f};
#pragma unroll
      for (int q = 0; q < 4; ++q) {
        const int bj = q >> 1, n = q & 1;
        int c = bcol + bj * 128 + wc * 32 + n * 16 + fr;
        float v[4];
#pragma unroll
        for (int pr = 0; pr < 2; ++pr) {
          float2 t = tc[q][pr];
          float r = dpp_swap1(odd ? t.x : t.y);
          v[2 * pr] = odd ? r : t.x; v[2 * pr + 1] = odd ? t.y : r;
        }
#pragma unroll
        for (int j = 0; j < 4; ++j) { v[j] += acc[ai][bj][m][n][j]; sq[j] += v[j] * v[j]; }
        store_rm4(x1b, 1024, row0, c, v[0], v[1], v[2], v[3], odd);
      }
#pragma unroll
      for (int j = 0; j < 4; ++j) {
        float t = row16_sum(sq[j]);
        if (fr == 0) ssq1[(size_t)(row0 + j) * 16 + slot] = t;
      }
      __builtin_amdgcn_sched_barrier(0);
#pragma unroll
      for (int q = 0; q < 4; ++q) { tc[q][0] = tn[q][0]; tc[q][1] = tn[q][1]; }
    }
  }
};

struct EpiGU {
  P p; static constexpr bool twice = false;
  __device__ __forceinline__ void operator()(f32x4 (&acc)[2][2][4][2], int brow, int bcol, int wr, int wc, int fr, int fq) const {
    const float* ssq1 = (const float*)(p.ws + OFF_SSQ1);
    u16* act = (u16*)(p.ws + OFF_ACT);
    int t = bcol >> 8;
    float sv[2][4][4];
#pragma unroll
    for (int ai = 0; ai < 2; ++ai)
#pragma unroll
      for (int m = 0; m < 4; ++m)
#pragma unroll
        for (int j = 0; j < 4; ++j) sv[ai][m][j] = ssq1[(size_t)(brow + ai * 128 + wr * 64 + m * 16 + fq * 4 + j) * 16 + fr];
    __builtin_amdgcn_sched_barrier(0);
#pragma unroll
    for (int ai = 0; ai < 2; ++ai)
#pragma unroll
      for (int m = 0; m < 4; ++m) {
        int row0 = brow + ai * 128 + wr * 64 + m * 16 + fq * 4;
        float rs[4];
#pragma unroll
        for (int j = 0; j < 4; ++j) rs[j] = rsqrtf(row16_sum(sv[ai][m][j]) * (1.f / 1024.f) + 1e-6f);
#pragma unroll
        for (int n = 0; n < 2; ++n) {
          float a[4];
#pragma unroll
          for (int j = 0; j < 4; ++j) {
            float g = acc[ai][0][m][n][j] * rs[j], u = acc[ai][1][m][n][j] * rs[j];
            a[j] = fast_silu(g) * u;
          }
          store_rm4(act, 2816, row0, t * 128 + wc * 32 + n * 16 + fr, a[0], a[1], a[2], a[3], fr & 1);
        }
        __builtin_amdgcn_sched_barrier(0);
      }
  }
};

struct EpiDown {
  P p;
  __device__ __forceinline__ void operator()(f32x4 (&acc)[2][2][4][2], int brow, int bcol, int wr, int wc, int fr, int fq) const {
    const u16* x1b = (const u16*)(p.ws + OFF_X1B);
    float sq[2][4][4];
#pragma unroll
    for (int ai = 0; ai < 2; ++ai)
#pragma unroll
      for (int m = 0; m < 4; ++m) {
        int row0 = brow + ai * 128 + wr * 64 + m * 16 + fq * 4;
#pragma unroll
        for (int j = 0; j < 4; ++j) {
          float s = 0.f;
#pragma unroll
          for (int bj = 0; bj < 2; ++bj)
#pragma unroll
            for (int n = 0; n < 2; ++n) {
              int c = bcol + bj * 128 + wc * 32 + n * 16 + fr;
              size_t o = (size_t)(row0 + j) * 1024 + c;
              float v = bf2f(x1b[o]) + acc[ai][bj][m][n][j];
              p.out[o] = v;
              s += v * v;
            }
          sq[ai][m][j] = s;
        }
      }
    ssq_store(sq, (float*)(p.ws + OFF_SSQ2), brow, (bcol >> 8) * 4 + wc, wr, fr, fq);
  }
};

struct EpiDownF {
  P p; static constexpr bool twice = false;
  __device__ __forceinline__ void operator()(f32x4 (&acc)[2][2][4][2], int brow, int bcol, int wr, int wc, int fr, int fq) const {
    extern __shared__ __attribute__((aligned(16))) u16 shm[];
    float* part = (float*)((char*)shm + 3 * HT * 2);
    float* rsl = part + 1024;
    const u16* x1b = (const u16*)(p.ws + OFF_X1B);
    unsigned long long* gran = (unsigned long long*)(p.ws + OFF_SSQ2);
    int ntile = bcol >> 8;
    int tid = (wr * 4 + wc) * 64 + fq * 16 + fr;
#pragma unroll
    for (int ai = 0; ai < 2; ++ai)
#pragma unroll
      for (int m = 0; m < 4; ++m) {
        int rl0 = ai * 128 + wr * 64 + m * 16 + fq * 4;
        float sq[4] = {0.f, 0.f, 0.f, 0.f};
#pragma unroll
        for (int bj = 0; bj < 2; ++bj)
#pragma unroll
          for (int n = 0; n < 2; ++n) {
            int c = bcol + bj * 128 + wc * 32 + n * 16 + fr;
            float xv[4];
            load_rm4_bf16(x1b + (size_t)(brow + rl0) * 1024, 1024, c, fr & 1, xv);
#pragma unroll
            for (int j = 0; j < 4; ++j) {
              float v = xv[j] + acc[ai][bj][m][n][j];
              acc[ai][bj][m][n][j] = v;
              sq[j] += v * v;
            }
          }
#pragma unroll
        for (int j = 0; j < 4; ++j) {
          float s = sq[j];
          s = row16_sum(s);
          if (fr == 0) part[(rl0 + j) * 4 + wc] = s;
        }
        __builtin_amdgcn_sched_barrier(0);
      }
    __syncthreads();
    if (tid < 256) {
      float s = part[tid * 4] + part[tid * 4 + 1] + part[tid * 4 + 2] + part[tid * 4 + 3];
      unsigned long long g = (unsigned long long)__float_as_uint(s) | (1ull << 32);
      __hip_atomic_store(gran + (size_t)(brow + tid) * 4 + ntile, g, __ATOMIC_RELAXED, __HIP_MEMORY_SCOPE_AGENT);
    }
    asm volatile("s_waitcnt vmcnt(0)" ::: "memory");
    __syncthreads();
    unsigned* cnt = (unsigned*)(p.ws + OFF_CNT) + (brow >> 8);
    if (tid == 0) {
      __hip_atomic_fetch_add(cnt, 1u, __ATOMIC_RELAXED, __HIP_MEMORY_SCOPE_AGENT);
      while (__hip_atomic_load(cnt, __ATOMIC_RELAXED, __HIP_MEMORY_SCOPE_AGENT) < 4u) __builtin_amdgcn_s_sleep(2);
    }
    __syncthreads();
    if (tid < 256) {
      float tot = 0.f;
#pragma unroll
      for (int q = 0; q < 4; ++q) {
        unsigned long long g;
        do { g = __hip_atomic_load(gran + (size_t)(brow + tid) * 4 + q, __ATOMIC_RELAXED, __HIP_MEMORY_SCOPE_AGENT); } while ((unsigned)(g >> 32) != 1u);
        tot += __uint_as_float((unsigned)g);
      }
      rsl[tid] = rsqrtf(tot * (1.f / 1024.f) + 1e-6f);
    }
    __syncthreads();
#pragma unroll
    for (int ai = 0; ai < 2; ++ai)
#pragma unroll
      for (int m = 0; m < 4; ++m) {
        int rl0 = ai * 128 + wr * 64 + m * 16 + fq * 4;
        float4 r4 = *(const float4*)(rsl + rl0);
        float rr[4] = {r4.x, r4.y, r4.z, r4.w};
#pragma unroll
        for (int bj = 0; bj < 2; ++bj)
#pragma unroll
          for (int n = 0; n < 2; ++n) {
            int c = bcol + bj * 128 + wc * 32 + n * 16 + fr;
            float gf = p.g_final[c];
            store_rm4_f32(p.out + (size_t)(brow + rl0) * 1024, 1024, c, fr & 1, acc[ai][bj][m][n][0] * rr[0] * gf,
                          acc[ai][bj][m][n][1] * rr[1] * gf, acc[ai][bj][m][n][2] * rr[2] * gf, acc[ai][bj][m][n][3] * rr[3] * gf);
          }
        __builtin_amdgcn_sched_barrier(0);
      }
  }
};

__device__ void phase_final(const P& p) {
  int tid = opaque_tid(p); int lane = tid & 63, wid = tid >> 6;
  const float* ssq2 = (const float*)(p.ws + OFF_SSQ2);
  for (int row = blockIdx.x * 8 + wid; row < NTOK; row += gridDim.x * 8) {
    float v = ssq2[(size_t)row * 16 + (lane & 15)];
    v = row16_sum(v);
    float rs = rsqrtf(v * (1.f / 1024.f) + 1e-6f);
    float4* o = (float4*)(p.out + (size_t)row * 1024);
    const float4* g = (const float4*)p.g_final;
#pragma unroll
    for (int i = 0; i < 4; ++i) {
      float4 x = o[lane + i * 64], gg = g[lane + i * 64];
      x.x *= rs * gg.x; x.y *= rs * gg.y; x.z *= rs * gg.z; x.w *= rs * gg.w;
      o[lane + i * 64] = x;
    }
  }
}

#define XB_TMO      128
#define XB_XCNT(j)  (256  + 64 * (j))
#define XB_XSUB(j)  (1280 + 64 * (j))
#define XB_XGEN(j)  (2304 + 64 * (j))
#define XB_TOP      3328
#define XB_TOPGEN   3392
#define XCD_BAR_WORDS 3456
#define XB_SPIN_CAP (1u << 18)
#define LAS __attribute__((address_space(3)))
__device__ __forceinline__ unsigned xb_ld(unsigned* q)              { return __hip_atomic_load(q, __ATOMIC_RELAXED, __HIP_MEMORY_SCOPE_AGENT); }
__device__ __forceinline__ unsigned xb_add(unsigned* q, unsigned v) { return __hip_atomic_fetch_add(q, v, __ATOMIC_RELAXED, __HIP_MEMORY_SCOPE_AGENT); }
__device__ __forceinline__ unsigned xb_xcc_id() { return (unsigned)__builtin_amdgcn_s_getreg((3 << 11) | 20) & 0xFu; }
#define XB_SPIN(cond, bar) do { unsigned _sp = 0; while (cond) { __builtin_amdgcn_s_sleep(1); \
    if ((++_sp & 255u) == 0u) { if (xb_ld(&(bar)[XB_TMO])) break; if (_sp > XB_SPIN_CAP) { atomicAdd(&(bar)[XB_TMO], 1u); break; } } } } while (0)
struct XcdBarrier { unsigned* bar; unsigned x; volatile LAS unsigned* st; };

__device__ __forceinline__ void xcd_barrier_complete(unsigned* bar, unsigned x, unsigned& nloc, unsigned& nx) {
  const unsigned G = gridDim.x * gridDim.y * gridDim.z;
  unsigned sum, cnt, mine, sp = 0u;
  for (;;) {
    sum = 0u; cnt = 0u; mine = 0u;
#pragma unroll
    for (unsigned j = 0; j < 16; ++j) { const unsigned c = xb_ld(&bar[XB_XCNT(j)]); sum += c; cnt += (c > 0u) ? 1u : 0u; mine = (j == x) ? c : mine; }
    if (sum == G) break;
    __builtin_amdgcn_s_sleep(1);
    if ((++sp & 255u) == 0u) { if (xb_ld(&bar[XB_TMO])) break; if (sp > XB_SPIN_CAP) { atomicAdd(&bar[XB_TMO], 1u); break; } }
  }
  nloc = mine > 0u ? mine : 1u; nx = cnt > 0u ? cnt : 1u;
}

__device__ __forceinline__ void xcd_barrier(const XcdBarrier& b, const P& p) {
  asm volatile("s_waitcnt vmcnt(0)" ::: "memory");
  __syncthreads();
  if (opaque_tid(p) == 0) {
    unsigned* bar = b.bar;
    __builtin_amdgcn_s_waitcnt(0);
    unsigned nloc = b.st[0], nx = b.st[1];
    if (nloc == 0u) { xcd_barrier_complete(bar, b.x, nloc, nx); b.st[0] = nloc; b.st[1] = nx; }
    const unsigned old = xb_add(&bar[XB_XSUB(b.x)], 1u);
    const unsigned gen = old / nloc;
    if (old + 1u == (gen + 1u) * nloc) {
      __builtin_amdgcn_fence(__ATOMIC_RELEASE, "agent");
      asm volatile("s_waitcnt vmcnt(0)" ::: "memory");
      const unsigned og = xb_add(&bar[XB_TOP], 1u);
      const unsigned tg = og / nx;
      if (og + 1u == (tg + 1u) * nx) xb_add(&bar[XB_TOPGEN], 1u);
      else XB_SPIN(xb_ld(&bar[XB_TOPGEN]) == tg, bar);
      __builtin_amdgcn_fence(__ATOMIC_ACQUIRE, "agent");
      xb_add(&bar[XB_XGEN(b.x)], 1u);
      asm volatile("s_waitcnt vmcnt(0)" ::: "memory");
    } else {
      XB_SPIN(xb_ld(&bar[XB_XGEN(b.x)]) == gen, bar);
      __builtin_amdgcn_fence(__ATOMIC_ACQUIRE, "agent");
      asm volatile("s_waitcnt vmcnt(0)" ::: "memory");
    }
  }
  __syncthreads();
}

__device__ __forceinline__ void run_phase(const P& p, int ph) {
  switch (ph) {
    case 0: phase_prep(p); break;
    case 1: gemm_phase((const u16*)(p.ws + OFF_XB), (const u16*)(p.ws + OFF_WIN), 1024, 13, EpiIn{p}); break;
    case 2: phase_gla_summ(p); phase_attn(p); break;
    case 3: phase_gla_scan(p); break;
    case 4: phase_gla_out(p); break;
    case 5: gemm_phase((const u16*)(p.ws + OFF_OMIX), (const u16*)(p.ws + OFF_WOUT), 1024, 4, EpiOut{p}); break;
    case 6: gemm_phase((const u16*)(p.ws + OFF_X1B), (const u16*)(p.ws + OFF_WGU), 1024, 22, EpiGU{p}); break;
#if MEGA && FUSE_FINAL
    case 7: gemm_phase((const u16*)(p.ws + OFF_ACT), (const u16*)(p.ws + OFF_WDN), 2816, 4, EpiDownF{p}); break;
    case 8: break;
#else
    case 7: gemm_phase((const u16*)(p.ws + OFF_ACT), (const u16*)(p.ws + OFF_WDN), 2816, 4, EpiDown{p}); break;
    case 8: phase_final(p); break;
#endif
    case 9: phase_attn(p); break;
    case 10: phase_gla_summ(p); break;
  }
}

#if MEGA
__global__ void __launch_bounds__(512) fwd_mega(P pin) {
  cg::grid_group grid = cg::this_grid();
  P p = pin; p.wv = __builtin_amdgcn_readfirstlane((int)(threadIdx.x >> 6));
  __shared__ uint4 xb_words;
  if (threadIdx.x == 0) {
    xb_words = make_uint4(0u, 0u, 0u, 0u);
  }
  __syncthreads();
  XcdBarrier xb;
  xb.bar = (unsigned*)(p.ws + OFF_BAR); xb.x = xb_xcc_id(); xb.st = (volatile LAS unsigned*)&xb_words;
  if (threadIdx.x == 0) xb_words.z = xb_add(&xb.bar[XB_XCNT(xb.x)], 1u);
  p.vx = __builtin_amdgcn_readfirstlane((int)(blockIdx.x & 7)); p.vj = __builtin_amdgcn_readfirstlane((int)(blockIdx.x >> 3));
  grid.sync();
  run_phase(p, 0); xcd_barrier(xb, p);
  {
    if (opaque_tid(p) == 0) {
      bool ok = true;
#pragma unroll
      for (unsigned j = 0; j < 16; ++j) { unsigned c = xb_ld(&xb.bar[XB_XCNT(j)]); ok = ok && (c == (j < 8 ? 32u : 0u)); }
      xb_words.w = ok ? 1u : 0u;
    }
    __syncthreads();
    {
      int okf = __builtin_amdgcn_readfirstlane((int)xb_words.w);
      int zj = __builtin_amdgcn_readfirstlane((int)xb_words.z);
      bool use = okf != 0 && xb.x < 8u;
      int nvx = use ? (int)xb.x : p.vx, nvj = use ? zj : p.vj;
      p.vx = __builtin_amdgcn_readfirstlane(nvx); p.vj = __builtin_amdgcn_readfirstlane(nvj);
    }
    __syncthreads();
  }
  run_phase(p, 1); xcd_barrier(xb, p);
  run_phase(p, 2); xcd_barrier(xb, p);
  run_phase(p, 3); xcd_barrier(xb, p);
  run_phase(p, 4); xcd_barrier(xb, p);
  run_phase(p, 5); xcd_barrier(xb, p);
  run_phase(p, 6); xcd_barrier(xb, p);
  run_phase(p, 7);
#if !FUSE_FINAL
  xcd_barrier(xb, p); run_phase(p, 8);
#endif
}
#else
template <int PH>
__global__ void __launch_bounds__(512) fwd_phase(P pin) { P p = pin; p.wv = __builtin_amdgcn_readfirstlane((int)(threadIdx.x >> 6)); p.vx = (int)(blockIdx.x & 7); p.vj = (int)(blockIdx.x >> 3); run_phase(p, PH); }
#endif

extern "C" void kernel_launch(void* const* d_in, const int* in_sizes, int n_in, void* d_out, int out_size,
                              void* d_ws, size_t ws_size, hipStream_t stream) {
  if (ws_size < WS_NEED) { fprintf(stderr, "workspace too small: %zu\n", ws_size); return; }
  P p{};
  p.xp = (const float*)d_in[0]; p.xs = (const float*)d_in[1]; p.g_mix = (const float*)d_in[2];
  p.w_in = (const float*)d_in[3]; p.wgf = (const float*)d_in[4]; p.bgf = (const float*)d_in[5];
  p.wgb = (const float*)d_in[6]; p.bgb = (const float*)d_in[7]; p.g_gla = (const float*)d_in[8];
  p.w_out = (const float*)d_in[9]; p.g_ffn = (const float*)d_in[10]; p.w_fg = (const float*)d_in[11];
  p.w_fu = (const float*)d_in[12]; p.w_fd = (const float*)d_in[13]; p.g_final = (const float*)d_in[14];
  p.out = (float*)d_out; p.ws = (char*)d_ws;
#if MEGA
  static int grid_blocks = 0;
  if (!grid_blocks) {
    hipFuncSetAttribute((const void*)fwd_mega, hipFuncAttributeMaxDynamicSharedMemorySize, SHM_BYTES);
    int dev = 0, cus = 0, per_cu = 0;
    hipGetDevice(&dev);
    hipDeviceGetAttribute(&cus, hipDeviceAttributeMultiprocessorCount, dev);
    hipOccupancyMaxActiveBlocksPerMultiprocessor(&per_cu, fwd_mega, 512, SHM_BYTES);
    if (per_cu < 1) per_cu = 1;
    grid_blocks = cus * per_cu;
    if (grid_blocks > 256) grid_blocks = 256;
  }
  if (grid_blocks != 256) { fprintf(stderr, "need 256 resident blocks, have %d\n", grid_blocks); return; }
  hipMemsetAsync((char*)d_ws + OFF_BAR, 0, XCD_BAR_WORDS * 4, stream);
  void* args[] = {&p};
  hipError_t e = hipLaunchCooperativeKernel((const void*)fwd_mega, dim3(grid_blocks), dim3(512), args, SHM_BYTES, stream);
  if (e != hipSuccess) fprintf(stderr, "cooperative launch failed: %s (grid %d)\n", hipGetErrorString(e), grid_blocks);
#else
#define LAUNCH(PH) do { hipFuncSetAttribute((const void*)fwd_phase<PH>, hipFuncAttributeMaxDynamicSharedMemorySize, SHM_BYTES); \
    fwd_phase<PH><<<256, 512, SHM_BYTES, stream>>>(p); } while (0)
  LAUNCH(0); LAUNCH(1); LAUNCH(2); LAUNCH(3); LAUNCH(4); LAUNCH(5); LAUNCH(6); LAUNCH(7); LAUNCH(8);
#endif
}
```

```cpp
#include <hip/hip_runtime.h>
#include <hip/hip_cooperative_groups.h>
#include <cstdio>
#include <cstdint>
namespace cg = cooperative_groups;

#ifndef MEGA
#define MEGA 1
#endif
#ifndef FUSE_FINAL
#define FUSE_FINAL 1
#endif

typedef unsigned short u16;
using bf16x8 = __attribute__((ext_vector_type(8))) short;
using f32x4  = __attribute__((ext_vector_type(4))) float;

constexpr int NTOK = 65536;
constexpr int NT_P = 32768;
constexpr size_t MiB = (size_t)1 << 20;
constexpr int SHM_BYTES = 131072;

constexpr size_t OFF_XB   = 0;
constexpr size_t OFF_OMIX = 0;
constexpr size_t OFF_VDT  = 128 * MiB;
constexpr size_t OFF_VAT  = 192 * MiB;
constexpr size_t OFF_RA   = 256 * MiB;
constexpr size_t OFF_QA   = 320 * MiB;
constexpr size_t OFF_KA   = 352 * MiB;
constexpr size_t OFF_LAF  = 384 * MiB;
constexpr size_t OFF_LAB  = 416 * MiB;
constexpr size_t OFF_WIN  = 448 * MiB;
constexpr size_t OFF_X1B  = 352 * MiB;
constexpr size_t OFF_ACT  = 0;
constexpr size_t OFF_WOUT = 480 * MiB;
constexpr size_t OFF_WGU  = 482 * MiB;
constexpr size_t OFF_WDN  = 493 * MiB;
constexpr size_t OFF_ROPE = 499 * MiB;
constexpr size_t OFF_RS1  = 499 * MiB + 512 * 1024;
constexpr size_t OFF_DEC  = 500 * MiB;
constexpr size_t OFF_SSQ1 = 502 * MiB;
constexpr size_t OFF_SSQ2 = 506 * MiB;
constexpr size_t OFF_CNT  = 510 * MiB;
constexpr size_t OFF_BAR  = 510 * MiB + 4096;
constexpr size_t OFF_WGT  = 510 * MiB + 4096 + 16384;
constexpr size_t WS_NEED  = 510 * MiB + 4096 + 16384 + 16384;
constexpr size_t OUT_KV = 0, OUT_QD = 128 * MiB, OUT_KD = 192 * MiB;

struct P {
  const float *xp, *xs, *g_mix, *w_in, *wgf, *bgf, *wgb, *bgb, *g_gla, *w_out, *g_ffn, *w_fg, *w_fu, *w_fd, *g_final;
  float* out;
  char* ws;
  int wv;
  int vx, vj;
  int pad_;
};

typedef __bf16 bf16v2 __attribute__((ext_vector_type(2)));
typedef float f32v2 __attribute__((ext_vector_type(2)));
__device__ __forceinline__ u16 f2bf(float f) { __bf16 h = (__bf16)f; return __builtin_bit_cast(u16, h); }
__device__ __forceinline__ float bf2f(u16 h) { return __uint_as_float(((unsigned)h) << 16); }
__device__ __forceinline__ unsigned pack2(float a, float b) {
  f32v2 f = {a, b}; bf16v2 h = __builtin_convertvector(f, bf16v2); return __builtin_bit_cast(unsigned, h);
}
__device__ __forceinline__ float dpp_swap1(float v) {
  return __uint_as_float((unsigned)__builtin_amdgcn_update_dpp(0, (int)__float_as_uint(v), 0xB1, 0xF, 0xF, true));
}
__device__ __forceinline__ void store_rm4(u16* dst, size_t ld, int row0, int c, float v0, float v1, float v2, float v3, bool odd) {
  {
    float s = odd ? v0 : v1, r = dpp_swap1(s);
    float lo = odd ? r : v0, hi = odd ? v1 : r;
    *(unsigned*)(dst + (size_t)(row0 + (odd ? 1 : 0)) * ld + (c - (odd ? 1 : 0))) = pack2(lo, hi);
  }
  {
    float s = odd ? v2 : v3, r = dpp_swap1(s);
    float lo = odd ? r : v2, hi = odd ? v3 : r;
    *(unsigned*)(dst + (size_t)(row0 + 2 + (odd ? 1 : 0)) * ld + (c - (odd ? 1 : 0))) = pack2(lo, hi);
  }
}
template <int CTRL> __device__ __forceinline__ float dpp_f(float v) {
  return __uint_as_float((unsigned)__builtin_amdgcn_update_dpp(0, (int)__float_as_uint(v), CTRL, 0xF, 0xF, true));
}
__device__ __forceinline__ float row16_sum(float v) {
  v += dpp_f<0x128>(v); v += dpp_f<0x124>(v); v += dpp_f<0x122>(v); v += dpp_f<0x121>(v);
  return v;
}
__device__ __forceinline__ void load_rm4_f32(const float* base, size_t ld, int c, bool odd, float (&x)[4]) {
#pragma unroll
  for (int pr = 0; pr < 2; ++pr) {
    float2 t = *(const float2*)(base + (size_t)(2 * pr + (odd ? 1 : 0)) * ld + (c - (odd ? 1 : 0)));
    float r = dpp_swap1(odd ? t.x : t.y);
    x[2 * pr] = odd ? r : t.x; x[2 * pr + 1] = odd ? t.y : r;
  }
}
__device__ __forceinline__ void load_rm4_bf16(const u16* base, size_t ld, int c, bool odd, float (&x)[4]) {
#pragma unroll
  for (int pr = 0; pr < 2; ++pr) {
    unsigned w = *(const unsigned*)(base + (size_t)(2 * pr + (odd ? 1 : 0)) * ld + (c - (odd ? 1 : 0)));
    float lo = __uint_as_float(w << 16), hi = __uint_as_float(w & 0xffff0000u);
    float r = dpp_swap1(odd ? lo : hi);
    x[2 * pr] = odd ? r : lo; x[2 * pr + 1] = odd ? hi : r;
  }
}
__device__ __forceinline__ void store_rm4_f32(float* base, size_t ld, int c, bool odd, float v0, float v1, float v2, float v3) {
  {
    float r = dpp_swap1(odd ? v0 : v1);
    float2 w; w.x = odd ? r : v0; w.y = odd ? v1 : r;
    *(float2*)(base + (size_t)(odd ? 1 : 0) * ld + (c - (odd ? 1 : 0))) = w;
  }
  {
    float r = dpp_swap1(odd ? v2 : v3);
    float2 w; w.x = odd ? r : v2; w.y = odd ? v3 : r;
    *(float2*)(base + (size_t)(2 + (odd ? 1 : 0)) * ld + (c - (odd ? 1 : 0))) = w;
  }
}
__device__ __forceinline__ float fast_silu(float z) { return z * __builtin_amdgcn_rcpf(1.f + __expf(-z)); }
__device__ __forceinline__ int opaque_tid(const P& p) {
  int lane;
  asm volatile("v_mbcnt_lo_u32_b32 %0, -1, 0\n\tv_mbcnt_hi_u32_b32 %0, -1, %0" : "=v"(lane));
  return p.wv * 64 + lane;
}
__device__ __forceinline__ const float* xrow(const P& p, int tok) {
  return tok < NT_P ? p.xp + (size_t)tok * 1024 : p.xs + (size_t)(tok - NT_P) * 1024;
}

constexpr int BK = 64, HALF = 128, HT = HALF * BK;

__device__ __forceinline__ int lds_byte(int r, int c) {
  int st = (r >> 4) * 2 + (c >> 5), rr = r & 15, cc = c & 31, ob = rr * 64 + cc * 2;
  return st * 1024 + (ob ^ (((ob >> 9) & 1) << 5));
}
__device__ __forceinline__ void stage_rc(int b, int& R, int& C) {
  int st = b / 1024, sb = b % 1024, swz = sb ^ (((sb >> 9) & 1) << 5);
  R = (st >> 1) * 16 + swz / 64; C = (st & 1) * 32 + (swz % 64) / 2;
}

template <class Epi>
__device__ __forceinline__ void gemm_tile(const u16* __restrict__ A, const u16* __restrict__ Bt, int K,
                                          int brow, int bcol, bool first, bool has_next, int nbrow, int nbcol, Epi epi) {
  extern __shared__ __attribute__((aligned(16))) u16 shm[];
#define SA(b, h) (shm + ((b) * 2 + (h)) * HT)
#define SB(b, h) (shm + (4 + (b) * 2 + (h)) * HT)
#define STAGE(Pp, BASE, br, kt) do { const char* _gb = (const char*)((BASE) + (long)(br) * K + (long)(kt) * BK); \
    __builtin_amdgcn_global_load_lds((const unsigned*)(_gb + voff0), \
        (__attribute__((address_space(3))) unsigned*)((char*)(Pp) + tidx * 16), 16, 0, 0); \
    __builtin_amdgcn_global_load_lds((const unsigned*)(_gb + voff1), \
        (__attribute__((address_space(3))) unsigned*)((char*)(Pp) + tidx * 16 + 8192), 16, 0, 0); } while (0)
#define LDA(dst, b, h) for (int m = 0; m < 4; ++m) for (int k = 0; k < 2; ++k) \
    dst[m][k] = *reinterpret_cast<const bf16x8*>((char*)SA(b, h) + lds_byte(wr * 64 + m * 16 + fr, k * 32 + fq * 8))
#define LDB(dst, b, h) for (int n = 0; n < 2; ++n) for (int k = 0; k < 2; ++k) \
    dst[n][k] = *reinterpret_cast<const bf16x8*>((char*)SB(b, h) + lds_byte(wc * 32 + n * 16 + fr, k * 32 + fq * 8))
#define MMA(ai, bj, At, Bq) do { __builtin_amdgcn_s_setprio(1); \
    for (int m = 0; m < 4; ++m) for (int n = 0; n < 2; ++n) for (int k = 0; k < 2; ++k) \
      acc[ai][bj][m][n] = __builtin_amdgcn_mfma_f32_16x16x32_bf16(At[m][k], Bq[n][k], acc[ai][bj][m][n], 0, 0, 0); \
    __builtin_amdgcn_s_setprio(0); } while (0)
#define WAIT_V(n) asm volatile("s_waitcnt vmcnt(" #n ")" ::: "memory")
#define WAIT_L(n) asm volatile("s_waitcnt lgkmcnt(" #n ")" ::: "memory")
#define BAR __builtin_amdgcn_s_barrier()
#define SCHED __builtin_amdgcn_sched_barrier(0)

  const int tidx = opaque_tid(epi.p);
  int wid = tidx >> 6, lane = tidx & 63, wr = wid >> 2, wc = wid & 3, fr = lane & 15, fq = lane >> 4;
  unsigned voff0, voff1;
  { int _r, _c; stage_rc(tidx * 16, _r, _c); voff0 = (unsigned)(_r * K + _c) * 2u;
    stage_rc(tidx * 16 + 8192, _r, _c); voff1 = (unsigned)(_r * K + _c) * 2u; }
  f32x4 acc[2][2][4][2] = {};
  bf16x8 At[4][2], B0[2][2], B1[2][2];
  int nt = K / BK;
  if (first) {
    STAGE(SB(0, 0), Bt, bcol, 0); STAGE(SA(0, 0), A, brow, 0);
    STAGE(SB(0, 1), Bt, bcol + HALF, 0); STAGE(SA(0, 1), A, brow + HALF, 0);
    if (wr == 1) BAR;
    WAIT_V(4); BAR;
    STAGE(SB(1, 0), Bt, bcol, 1); STAGE(SA(1, 0), A, brow, 1); STAGE(SB(1, 1), Bt, bcol + HALF, 1);
    WAIT_V(6); BAR;
  } else {
    if (wr == 1) BAR;
    WAIT_V(16); BAR;
  }
  for (int t = 0; t < nt - 2; t += 2) {
    LDB(B0, 0, 0); SCHED; LDA(At, 0, 0); STAGE(SA(1, 1), A, brow + HALF, t + 1);
    WAIT_L(8); BAR; WAIT_L(0); MMA(0, 0, At, B0); BAR; SCHED;
    LDB(B1, 0, 1); STAGE(SB(0, 0), Bt, bcol, t + 2);
    BAR; WAIT_L(0); MMA(0, 1, At, B1); BAR;
    LDA(At, 0, 1); STAGE(SA(0, 0), A, brow, t + 2);
    BAR; WAIT_L(0); MMA(1, 0, At, B0); BAR; SCHED;
    STAGE(SB(0, 1), Bt, bcol + HALF, t + 2);
    WAIT_V(6); BAR; MMA(1, 1, At, B1); BAR;
    LDB(B0, 1, 0); SCHED; LDA(At, 1, 0); STAGE(SA(0, 1), A, brow + HALF, t + 2);
    WAIT_L(8); BAR; WAIT_L(0); MMA(0, 0, At, B0); BAR; SCHED;
    LDB(B1, 1, 1); STAGE(SB(1, 0), Bt, bcol, t + 3);
    BAR; WAIT_L(0); MMA(0, 1, At, B1); BAR;
    LDA(At, 1, 1); STAGE(SA(1, 0), A, brow, t + 3);
    BAR; WAIT_L(0); MMA(1, 0, At, B0); BAR; SCHED;
    STAGE(SB(1, 1), Bt, bcol + HALF, t + 3);
    WAIT_V(6); BAR; MMA(1, 1, At, B1); BAR;
  }
  { LDB(B0, 0, 0); LDA(At, 0, 0); STAGE(SA(1, 1), A, brow + HALF, nt - 1);
    BAR; WAIT_L(0); MMA(0, 0, At, B0); BAR;
    LDB(B1, 0, 1); BAR; WAIT_L(0); MMA(0, 1, At, B1); BAR;
    LDA(At, 0, 1); WAIT_V(4); BAR; WAIT_L(0); MMA(1, 0, At, B0); MMA(1, 1, At, B1); BAR; }
  { LDB(B0, 1, 0); LDA(At, 1, 0); WAIT_V(2); BAR; WAIT_L(0); MMA(0, 0, At, B0); BAR;
    LDB(B1, 1, 1); WAIT_V(0); BAR; WAIT_L(0); MMA(0, 1, At, B1); BAR;
    LDA(At, 1, 1); BAR; WAIT_L(0); MMA(1, 0, At, B0); MMA(1, 1, At, B1); BAR; }
  if (wr == 0) BAR;
  if (has_next) {
    STAGE(SB(0, 0), Bt, nbcol, 0); STAGE(SA(0, 0), A, nbrow, 0);
    STAGE(SB(0, 1), Bt, nbcol + HALF, 0); STAGE(SA(0, 1), A, nbrow + HALF, 0);
    STAGE(SB(1, 0), Bt, nbcol, 1); STAGE(SA(1, 0), A, nbrow, 1); STAGE(SB(1, 1), Bt, nbcol + HALF, 1);
  }
  { int t2 = opaque_tid(epi.p);
    int w2 = t2 >> 6, l2 = t2 & 63;
    epi(acc, brow, bcol, w2 >> 2, w2 & 3, l2 & 15, l2 >> 4); }
  WAIT_L(0); BAR;
#undef SA
#undef SB
}

template <class Epi>
__device__ __forceinline__ void gemm_phase(const u16* A, const u16* Bt, int K, int nN, Epi epi) {
  {
    int x = epi.p.vx, j = epi.p.vj;
    int li = j;
    int mg = li / (nN * 8), rem = li % (nN * 8);
    int brow = (x * 32 + mg * 8 + (rem & 7)) * 256, bcol = (rem >> 3) * 256;
    for (int rd = 0; rd < nN; ++rd) {
      int nbrow = 0, nbcol = 0;
      bool has_next = rd + 1 < nN;
      if (has_next) {
        int l2 = (rd + 1) * 32 + j;
        int mg2 = l2 / (nN * 8), rem2 = l2 % (nN * 8);
        nbrow = (x * 32 + mg2 * 8 + (rem2 & 7)) * 256; nbcol = (rem2 >> 3) * 256;
      }
      gemm_tile(A, Bt, K, brow, bcol, rd == 0, has_next, nbrow, nbcol, epi);
      brow = nbrow; bcol = nbcol;
    }
  }
}

template <class Src>
__device__ __forceinline__ void wt_tile(u16* dst, int ldk, int n0, int k0, Src src, float* tile, int t) {
  int nl = t & 63, kb = t >> 6;
#pragma unroll
  for (int i = 0; i < 8; ++i) {
    int kl = kb + 8 * i;
    tile[kl * 65 + nl] = src(k0 + kl, n0 + nl);
  }
  __syncthreads();
#pragma unroll
  for (int i = 0; i < 8; ++i) {
    int n = kb + 8 * i;
    dst[(size_t)(n0 + n) * ldk + k0 + nl] = f2bf(tile[nl * 65 + n]);
  }
  __syncthreads();
}

__device__ void phase_prep(const P& p) {
  extern __shared__ __attribute__((aligned(16))) u16 shm[];
  float* tile = (float*)shm;
  int tid = opaque_tid(p), lane = tid & 63, wid = tid >> 6;
  u16* xb = (u16*)(p.ws + OFF_XB);
  float* rs1 = (float*)(p.ws + OFF_RS1);
  for (int row = (blockIdx.x * 8 + wid) * 2; row < NTOK; row += gridDim.x * 16) {
    const float4* src0 = (const float4*)xrow(p, row);
    const float4* src1 = (const float4*)xrow(p, row + 1);
    float4 v0[4], v1[4];
#pragma unroll
    for (int i = 0; i < 4; ++i) { v0[i] = src0[lane + i * 64]; v1[i] = src1[lane + i * 64]; }
    float ss0 = 0.f, ss1 = 0.f;
    uint2* dst0 = (uint2*)(xb + (size_t)row * 1024);
    uint2* dst1 = (uint2*)(xb + (size_t)(row + 1) * 1024);
#pragma unroll
    for (int i = 0; i < 4; ++i) {
      ss0 += v0[i].x * v0[i].x + v0[i].y * v0[i].y + v0[i].z * v0[i].z + v0[i].w * v0[i].w;
      ss1 += v1[i].x * v1[i].x + v1[i].y * v1[i].y + v1[i].z * v1[i].z + v1[i].w * v1[i].w;
      uint2 o; o.x = pack2(v0[i].x, v0[i].y); o.y = pack2(v0[i].z, v0[i].w); dst0[lane + i * 64] = o;
      o.x = pack2(v1[i].x, v1[i].y); o.y = pack2(v1[i].z, v1[i].w); dst1[lane + i * 64] = o;
    }
#pragma unroll
    for (int s2 = 32; s2 >= 1; s2 >>= 1) { ss0 += __shfl_xor(ss0, s2); ss1 += __shfl_xor(ss1, s2); }
    if (lane == 0) { rs1[row] = rsqrtf(ss0 * (1.f / 1024.f) + 1e-6f); rs1[row + 1] = rsqrtf(ss1 * (1.f / 1024.f) + 1e-6f); }
  }
  u16* win = (u16*)(p.ws + OFF_WIN);
  u16* wout = (u16*)(p.ws + OFF_WOUT);
  u16* wgu = (u16*)(p.ws + OFF_WGU);
  u16* wdn = (u16*)(p.ws + OFF_WDN);
  const int J0 = 768, J1 = J0 + 64, J2 = J1 + 256, J3 = J2 + 1408, J4 = J3 + 704;
  for (int it = blockIdx.x; it < J4; it += gridDim.x) {
    if (it < J0) {
      int n0 = (it >> 4) * 64, k0 = (it & 15) * 64;
      wt_tile(win, 1024, n0, k0, [&](int k, int n) { return p.w_in[(size_t)k * 3104 + n] * p.g_mix[k]; }, tile, tid);
    } else if (it < J1) {
      int q = it - J0; int n0 = (q >> 4) * 64, k0 = (q & 15) * 64;
      wt_tile(win + (size_t)3072 * 1024, 1024, n0, k0, [&](int k, int n) {
        return n < 32 ? p.w_in[(size_t)k * 3104 + 3072 + n] * p.g_mix[k] : 0.f; }, tile, tid);
    } else if (it < J2) {
      int q = it - J1; int n0 = (q >> 4) * 64, k0 = (q & 15) * 64;
      wt_tile(wout, 1024, n0, k0, [&](int k, int n) { return p.w_out[(size_t)k * 1024 + n]; }, tile, tid);
    } else if (it < J3) {
      int q = it - J2; int n0 = (q >> 4) * 64, k0 = (q & 15) * 64;
      wt_tile(wgu, 1024, n0, k0, [&](int k, int n) {
        int t = n >> 8, w = n & 255; int ff = t * 128 + (w & 127);
        const float* W = (w < 128) ? p.w_fg : p.w_fu;
        return W[(size_t)k * 2816 + ff] * p.g_ffn[k]; }, tile, tid);
    } else {
      int q = it - J3; int n0 = (q / 44) * 64, k0 = (q % 44) * 64;
      wt_tile(wdn, 2816, n0, k0, [&](int k, int n) { return p.w_fd[(size_t)k * 1024 + n]; }, tile, tid);
    }
  }
  if (blockIdx.x == 0 && tid < 256) ((unsigned*)(p.ws + OFF_CNT))[tid] = 0u;
#if FUSE_FINAL
  { uint4* g4 = (uint4*)(p.ws + OFF_SSQ2);
    for (int i = blockIdx.x * 512 + tid; i < (2 << 20) / 16; i += gridDim.x * 512) g4[i] = make_uint4(0u, 0u, 0u, 0u); }
#endif
  { u16* wgt = (u16*)(p.ws + OFF_WGT);
    for (int idx = blockIdx.x * 512 + tid; idx < 8192; idx += gridDim.x * 512) {
      int dir = idx >> 12, col = (idx >> 4) & 255, r = idx & 15;
      wgt[idx] = f2bf((dir ? p.wgb : p.wgf)[r * 256 + col]);
    } }
  float* rope = (float*)(p.ws + OFF_ROPE);
  for (int idx = blockIdx.x * 512 + tid; idx < 8192 * 8; idx += gridDim.x * 512) {
    int pos = idx >> 3, i = idx & 7;
    float inv = exp2f(-((float)i * 0.125f) * log2f(500000.f));
    float ang = (float)pos * inv;
    double a = (double)ang;
    double rr = a - 6.283185307179586 * rint(a * 0.15915494309189535);
    float rf = (float)rr;
    rope[idx * 2] = cosf(rf);
    rope[idx * 2 + 1] = sinf(rf);
  }
}

struct EpiIn {
  P p;
  __device__ __forceinline__ void operator()(f32x4 (&acc)[2][2][4][2], int brow, int bcol, int wr, int wc, int fr, int fq) const {
    const float* rs1 = (const float*)(p.ws + OFF_RS1);
    int nt = bcol >> 8;
    char* outb = (char*)p.out;
    float4 rsq[2][4];
#pragma unroll
    for (int ai = 0; ai < 2; ++ai)
#pragma unroll
      for (int m = 0; m < 4; ++m) rsq[ai][m] = *(const float4*)(rs1 + brow + ai * 128 + wr * 64 + m * 16 + fq * 4);
    __builtin_amdgcn_sched_barrier(0);
    if (nt < 4) {
      u16* dst = (u16*)(outb + (nt < 2 ? OUT_QD : OUT_KD));
      float sc = nt < 2 ? 0.125f * 1.4426950408889634f : 1.f;
      int cbase = (nt & 1) * 256;
      const float2* rope = (const float2*)(p.ws + OFF_ROPE);
      int posmask = brow < NT_P ? 4095 : 8191;
      bool rot = (wc & 1) == 0;
      float2 csc[4], csn[4];
#pragma unroll
      for (int j = 0; j < 4; ++j) csc[j] = rope[((brow + wr * 64 + fq * 4 + j) & posmask) * 8 + (fr & 7)];
#pragma unroll
      for (int ch = 0; ch < 8; ++ch) {
        const int ai = ch >> 2, m = ch & 3;
        int row0 = brow + ai * 128 + wr * 64 + m * 16 + fq * 4;
        if (ch + 1 < 8) {
          int rown = brow + ((ch + 1) >> 2) * 128 + wr * 64 + ((ch + 1) & 3) * 16 + fq * 4;
#pragma unroll
          for (int j = 0; j < 4; ++j) csn[j] = rope[((rown + j) & posmask) * 8 + (fr & 7)];
        }
        __builtin_amdgcn_sched_barrier(0);
        float4 r4 = rsq[ai][m];
        float rr[4] = {r4.x * sc, r4.y * sc, r4.z * sc, r4.w * sc};
        float va[2][4], vb[2][4];
#pragma unroll
        for (int j = 0; j < 4; ++j) {
          float2 cs = csc[j];
#pragma unroll
          for (int bj = 0; bj < 2; ++bj) {
            float v = acc[ai][bj][m][0][j];
            float pr = dpp_f<0x128>(v);
            float sg = (fr < 8) ? -pr : pr;
            float vr = v * cs.x + sg * cs.y;
            v = rot ? vr : v;
            va[bj][j] = v * rr[j];
            vb[bj][j] = acc[ai][bj][m][1][j] * rr[j];
          }
        }
#pragma unroll
        for (int bj = 0; bj < 2; ++bj) {
          int c = cbase + bj * 128 + wc * 32 + fr;
          store_rm4(dst, 512, row0, c, va[bj][0], va[bj][1], va[bj][2], va[bj][3], fr & 1);
          store_rm4(dst, 512, row0, c + 16, vb[bj][0], vb[bj][1], vb[bj][2], vb[bj][3], fr & 1);
        }
        __builtin_amdgcn_sched_barrier(0);
#pragma unroll
        for (int j = 0; j < 4; ++j) csc[j] = csn[j];
      }
    } else if (nt < 6) {
      u16* dst = (u16*)(p.ws + OFF_VDT);
      int L, seq0;
      if (brow < NT_P) { L = 4096; seq0 = brow & ~4095; } else { L = 8192; seq0 = NT_P + ((brow - NT_P) & ~8191); }
      int L16 = L >> 4;
      int cbase = (nt & 1) * 256;
#pragma unroll
      for (int ai = 0; ai < 2; ++ai) {
        int pos0 = brow - seq0 + ai * 128 + wr * 64;
        int idx16 = pos0 >> 4;
        float4 r4[4];
#pragma unroll
        for (int m = 0; m < 4; ++m) r4[m] = rsq[ai][m];
#pragma unroll
        for (int bj = 0; bj < 2; ++bj) {
#pragma unroll
          for (int n = 0; n < 2; ++n) {
            int c = cbase + bj * 128 + wc * 32 + n * 16 + fr;
            int h = c >> 6, d = c & 63;
            u16* dcol = dst + (size_t)seq0 * 512 + ((size_t)(h * 16 + fq * 4) * (L16 >> 2) + (idx16 >> 2)) * 256 + d * 4;
#pragma unroll
            for (int j = 0; j < 4; ++j) {
              uint2 o;
              float a0 = acc[ai][bj][0][n][j] * (j == 0 ? r4[0].x : j == 1 ? r4[0].y : j == 2 ? r4[0].z : r4[0].w);
              float a1 = acc[ai][bj][1][n][j] * (j == 0 ? r4[1].x : j == 1 ? r4[1].y : j == 2 ? r4[1].z : r4[1].w);
              float a2 = acc[ai][bj][2][n][j] * (j == 0 ? r4[2].x : j == 1 ? r4[2].y : j == 2 ? r4[2].z : r4[2].w);
              float a3 = acc[ai][bj][3][n][j] * (j == 0 ? r4[3].x : j == 1 ? r4[3].y : j == 2 ? r4[3].z : r4[3].w);
              o.x = pack2(a0, a1); o.y = pack2(a2, a3);
              *(uint2*)(dcol + (size_t)j * 64 * L16) = o;
            }
          }
          __builtin_amdgcn_sched_barrier(0);
        }
      }
    } else if (nt < 8) {
      u16* dst = (u16*)(p.ws + (nt == 6 ? OFF_QA : OFF_KA));
      float sc = nt == 6 ? 0.125f : 1.f;
#pragma unroll
      for (int ai = 0; ai < 2; ++ai)
#pragma unroll
        for (int m = 0; m < 4; ++m) {
          int row0 = brow + ai * 128 + wr * 64 + m * 16 + fq * 4;
          float4 r4 = rsq[ai][m];
          float rr[4] = {r4.x * sc, r4.y * sc, r4.z * sc, r4.w * sc};
#pragma unroll
          for (int bj = 0; bj < 2; ++bj)
#pragma unroll
            for (int n = 0; n < 2; ++n) {
              int c = bj * 128 + wc * 32 + n * 16 + fr;
              store_rm4(dst, 256, row0, c, acc[ai][bj][m][n][0] * rr[0], acc[ai][bj][m][n][1] * rr[1],
                        acc[ai][bj][m][n][2] * rr[2], acc[ai][bj][m][n][3] * rr[3], fr & 1);
            }
          __builtin_amdgcn_sched_barrier(0);
        }
    } else if (nt < 10) {
      u16* dst = (u16*)(p.ws + OFF_VAT);
      int cbase = (nt & 1) * 256;
#pragma unroll
      for (int ai = 0; ai < 2; ++ai) {
        int chunk = (brow + ai * 128 + wr * 64) >> 6;
#pragma unroll
        for (int m = 0; m < 4; ++m) {
          float4 r4 = rsq[ai][m];
#pragma unroll
          for (int bj = 0; bj < 2; ++bj)
#pragma unroll
            for (int n = 0; n < 2; ++n) {
              int c = cbase + bj * 128 + wc * 32 + n * 16 + fr;
              int h = c >> 7, dv = c & 127;
              uint2 o;
              o.x = pack2(acc[ai][bj][m][n][0] * r4.x, acc[ai][bj][m][n][1] * r4.y);
              o.y = pack2(acc[ai][bj][m][n][2] * r4.z, acc[ai][bj][m][n][3] * r4.w);
              *(uint2*)(dst + ((size_t)(chunk * 4 + h) * 128 + dv) * 64 + m * 16 + fq * 4) = o;
            }
          __builtin_amdgcn_sched_barrier(0);
        }
      }
    } else if (nt < 12) {
      u16* dst = (u16*)(p.ws + OFF_RA);
      int cbase = (nt & 1) * 256;
#pragma unroll
      for (int ai = 0; ai < 2; ++ai) {
        int chunk = (brow + ai * 128 + wr * 64) >> 6;
#pragma unroll
        for (int m = 0; m < 4; ++m) {
          float4 r4 = rsq[ai][m];
#pragma unroll
          for (int bj = 0; bj < 2; ++bj)
#pragma unroll
            for (int n = 0; n < 2; ++n) {
              int c = cbase + bj * 128 + wc * 32 + n * 16 + fr;
              int h = c >> 7, dv = c & 127;
              uint2 o;
              o.x = pack2(fast_silu(acc[ai][bj][m][n][0] * r4.x), fast_silu(acc[ai][bj][m][n][1] * r4.y));
              o.y = pack2(fast_silu(acc[ai][bj][m][n][2] * r4.z), fast_silu(acc[ai][bj][m][n][3] * r4.w));
              *(uint2*)(dst + ((size_t)(chunk * 4 + h) * 128 + dv) * 64 + m * 16 + fq * 4) = o;
            }
          __builtin_amdgcn_sched_barrier(0);
        }
      }
    } else {
      extern __shared__ __attribute__((aligned(16))) u16 shm[];
      u16* glr = (u16*)((char*)shm + 3 * HT * 2);
      if (wc == 0) {
#pragma unroll
        for (int ai = 0; ai < 2; ++ai)
#pragma unroll
          for (int m = 0; m < 4; ++m) {
            int rl0 = ai * 128 + wr * 64 + m * 16 + fq * 4;
            float4 r4 = rsq[ai][m];
            float rr[4] = {r4.x, r4.y, r4.z, r4.w};
#pragma unroll
            for (int n = 0; n < 2; ++n)
#pragma unroll
              for (int j = 0; j < 4; ++j) glr[(rl0 + j) * 32 + n * 16 + fr] = f2bf(acc[ai][0][m][n][j] * rr[j]);
          }
      }
      __syncthreads();
      typedef short s16x4 __attribute__((ext_vector_type(4)));
      const u16* wgt = (const u16*)(p.ws + OFF_WGT);
#pragma unroll
      for (int dir = 0; dir < 2; ++dir) {
        s16x4 bfr[2][2];
#pragma unroll
        for (int bj = 0; bj < 2; ++bj)
#pragma unroll
          for (int n = 0; n < 2; ++n)
            bfr[bj][n] = *(const s16x4*)(wgt + ((size_t)(dir * 256 + bj * 128 + wc * 32 + n * 16 + fr)) * 16 + fq * 4);
        u16* dst = (u16*)(p.ws + (dir == 0 ? OFF_LAF : OFF_LAB));
        const float* bias = dir == 0 ? p.bgf : p.bgb;
#pragma unroll
        for (int ai = 0; ai < 2; ++ai)
#pragma unroll
          for (int m = 0; m < 4; ++m) {
            int rl = ai * 128 + wr * 64 + m * 16;
            s16x4 af = *(const s16x4*)(glr + (rl + fr) * 32 + dir * 16 + fq * 4);
            int row0 = brow + rl + fq * 4;
#pragma unroll
            for (int bj = 0; bj < 2; ++bj)
#pragma unroll
              for (int n = 0; n < 2; ++n) {
                f32x4 z4 = {0.f, 0.f, 0.f, 0.f};
                z4 = __builtin_amdgcn_mfma_f32_16x16x16bf16_1k(af, bfr[bj][n], z4, 0, 0, 0);
                int c = bj * 128 + wc * 32 + n * 16 + fr;
                float bb = bias[c];
                float ls[4];
#pragma unroll
                for (int j = 0; j < 4; ++j) {
                  float z = z4[j] + bb;
                  ls[j] = (fminf(z, 0.f) - __logf(1.f + __expf(-fabsf(z)))) * (1.f / 16.f);
                }
                store_rm4(dst, 256, row0, c, ls[0], ls[1], ls[2], ls[3], fr & 1);
              }
            __builtin_amdgcn_sched_barrier(0);
          }
      }
    }
  }
};

typedef bf16x8 __attribute__((aligned(8))) bf16x8_a8;
struct KVB { bf16x8 k0, k1, k2, k3; bf16x8 v0, v1, v2, v3; };
constexpr int ATT_NKS = 23;

__device__ __forceinline__ void attn_desc(int ks, int g, int r, int i0, int& c, int& s) {
  if (ks < 12) { c = 4 * (ks & 3) + g; s = i0 - 4 + 8 * (ks >> 2); }
  else if (ks < 18) { c = (r & 3) + 4 * g; s = i0 - 16 + 8 * (ks - 12); }
  else { c = r; s = i0 - 64 + 8 * ((ks - 18) * 4 + g); }
}

__device__ __forceinline__ KVB attn_load(int ks, const u16* __restrict__ kbase, const u16* __restrict__ vbase, int L16,
                                         int r, int i0, int lane) {
  KVB b;
  const int quad = lane >> 4, l15 = lane & 15, gk = l15 >> 2, ek = l15 & 3;
  int cK, sK; attn_desc(ks, gk, r, i0, cK, sK);
  int ia = sK + ek, ib = ia + 4;
  ia = min(max(ia, 0), L16 - 1); ib = min(max(ib, 0), L16 - 1);
  const u16* ka = kbase + (size_t)(cK + 16 * ia) * 512;
  const u16* kb = kbase + (size_t)(cK + 16 * ib) * 512;
  b.k0 = *(const bf16x8*)ka; b.k1 = *(const bf16x8*)(ka + 8);
  b.k2 = *(const bf16x8*)kb; b.k3 = *(const bf16x8*)(kb + 8);
  int cV, sV; attn_desc(ks, quad, r, i0, cV, sV);
  const u16* vp = vbase + ((ptrdiff_t)cV * (L16 >> 2) + (sV >> 2)) * 256 + l15 * 4;
  {
    union { struct { uint2 a, b; } p; bf16x8 v; } c0, c1, c2, c3;
    c0.p.a = *(const uint2*)(vp);        c0.p.b = *(const uint2*)(vp + 256);
    c1.p.a = *(const uint2*)(vp + 64);   c1.p.b = *(const uint2*)(vp + 64 + 256);
    c2.p.a = *(const uint2*)(vp + 128);  c2.p.b = *(const uint2*)(vp + 128 + 256);
    c3.p.a = *(const uint2*)(vp + 192);  c3.p.b = *(const uint2*)(vp + 192 + 256);
    b.v0 = c0.v; b.v1 = c1.v; b.v2 = c2.v; b.v3 = c3.v;
  }
  return b;
}

__device__ __forceinline__ void attn_step(int ks, const KVB& b, int L16, int r, int i0, int iq, int lane,
                                          const bf16x8* qs, f32x4 (&o)[4], float& mrun, float& lrun) {
  asm volatile("" : "+v"(lane), "+v"(iq));
  asm volatile("" : "+s"(r), "+s"(i0));
  const int quad = lane >> 4;
  bf16x8 qB0 = qs[0], qB1 = qs[64];
  int cV, sV; attn_desc(ks, quad, r, i0, cV, sV);
  int D = ks < 12 ? 4 : (ks < 18 ? 16 : 64);
  f32x4 z = {0.f, 0.f, 0.f, 0.f};
  f32x4 sa = __builtin_amdgcn_mfma_f32_16x16x32_bf16(b.k0, qB0, z, 0, 0, 0);
  sa = __builtin_amdgcn_mfma_f32_16x16x32_bf16(b.k1, qB1, sa, 0, 0, 0);
  f32x4 sb = __builtin_amdgcn_mfma_f32_16x16x32_bf16(b.k2, qB0, z, 0, 0, 0);
  sb = __builtin_amdgcn_mfma_f32_16x16x32_bf16(b.k3, qB1, sb, 0, 0, 0);
  int jlo = max(iq - D + (cV < r ? 1 : 0), 0) - sV;
  int jhi = min(iq + D - (cV > r ? 1 : 0), L16 - 1) - sV;
  const float NINF = -__builtin_inff();
  float s8[8];
  float mt = -1e30f;
#pragma unroll
  for (int j = 0; j < 8; ++j) {
    float sv = j < 4 ? sa[j] : sb[j - 4];
    sv = (j >= jlo && j <= jhi) ? sv : NINF;
    s8[j] = sv;
    mt = fmaxf(mt, sv);
  }
  mt = fmaxf(mt, __shfl_xor(mt, 16));
  mt = fmaxf(mt, __shfl_xor(mt, 32));
  float mnew = fmaxf(mrun, mt);
  float alpha = __builtin_amdgcn_exp2f(mrun - mnew);
  bool grew = mnew > mrun;
  mrun = mnew;
  float ps = 0.f;
  float p8[8];
#pragma unroll
  for (int j = 0; j < 8; ++j) { p8[j] = __builtin_amdgcn_exp2f(s8[j] - mnew); ps += p8[j]; }
  lrun = lrun * alpha + ps;
  union { uint4 u; bf16x8 v; } pb;
  pb.u = make_uint4(pack2(p8[0], p8[1]), pack2(p8[2], p8[3]), pack2(p8[4], p8[5]), pack2(p8[6], p8[7]));
  if (__builtin_amdgcn_ballot_w64(grew) != 0) {
#pragma unroll
    for (int dt = 0; dt < 4; ++dt) { o[dt][0] *= alpha; o[dt][1] *= alpha; o[dt][2] *= alpha; o[dt][3] *= alpha; }
  }
  o[0] = __builtin_amdgcn_mfma_f32_16x16x32_bf16(b.v0, pb.v, o[0], 0, 0, 0);
  o[1] = __builtin_amdgcn_mfma_f32_16x16x32_bf16(b.v1, pb.v, o[1], 0, 0, 0);
  o[2] = __builtin_amdgcn_mfma_f32_16x16x32_bf16(b.v2, pb.v, o[2], 0, 0, 0);
  o[3] = __builtin_amdgcn_mfma_f32_16x16x32_bf16(b.v3, pb.v, o[3], 0, 0, 0);
}

template <int NT>
__device__ __forceinline__ KVB attn_load_e(int e, const u16* kbase, const u16* vbase, int L16, int rb, int i0, int lane) {
  int ks, r;
  if (e < 18) { ks = e; r = rb; } else { int f = e - 18; ks = 18 + f / NT; r = rb + (16 / NT) * (f % NT); }
  return attn_load(ks, kbase, vbase, L16, r, i0, lane);
}

template <int NT>
__device__ void attn_unitN(const P& p, int u) {
  constexpr int RS = 16 / NT;
  constexpr int EMAX = 18 + 5 * NT - 1;
  int lane = opaque_tid(p) & 63, q = lane & 15, quad = lane >> 4;
  int rb = u % RS, h = (u / RS) & 7, span = u / (RS * 8);
  int tb = span * 256;
  int seq0, L;
  if (tb < NT_P) { L = 4096; seq0 = tb & ~4095; } else { L = 8192; seq0 = NT_P + ((tb - NT_P) & ~8191); }
  int L16 = L >> 4;
  int i0 = (tb - seq0) >> 4;
  int iq = i0 + q;
  const u16* Qd = (const u16*)((const char*)p.out + OUT_QD);
  const u16* Kd = (const u16*)((const char*)p.out + OUT_KD);
  const u16* VdT = (const u16*)(p.ws + OFF_VDT);
  extern __shared__ __attribute__((aligned(16))) u16 shm[];
  bf16x8* qs = (bf16x8*)((char*)shm + __builtin_amdgcn_readfirstlane(opaque_tid(p) >> 6) * 8192) + lane;
  f32x4 o[NT][4];
  float mrun[NT], lrun[NT];
#pragma unroll
  for (int t = 0; t < NT; ++t) {
    const u16* qp = Qd + (size_t)(seq0 + rb + RS * t + 16 * iq) * 512 + h * 64 + quad * 16;
    qs[t * 128] = *(const bf16x8*)qp; qs[t * 128 + 64] = *(const bf16x8*)(qp + 8);
#pragma unroll
    for (int dt = 0; dt < 4; ++dt) o[t][dt] = f32x4{0.f, 0.f, 0.f, 0.f};
    mrun[t] = -1e30f; lrun[t] = 0.f;
  }
  const u16* kbase = Kd + (size_t)seq0 * 512 + h * 64 + quad * 16;
  const u16* vbase = VdT + (size_t)seq0 * 512 + (size_t)h * 16 * 64 * L16;
  KVB bA = attn_load_e<NT>(0, kbase, vbase, L16, rb, i0, lane);
  KVB bB = attn_load_e<NT>(1, kbase, vbase, L16, rb, i0, lane);
#pragma unroll 1
  for (int ks = 0; ks < 18; ks += 2) {
#pragma unroll
    for (int t = 0; t < NT; ++t)
      attn_step(ks, bA, L16, rb + RS * t, i0, iq, lane, qs + t * 128, o[t], mrun[t], lrun[t]);
    bA = attn_load_e<NT>(ks + 2, kbase, vbase, L16, rb, i0, lane);
#pragma unroll
    for (int t = 0; t < NT; ++t)
      attn_step(ks + 1, bB, L16, rb + RS * t, i0, iq, lane, qs + t * 128, o[t], mrun[t], lrun[t]);
    bB = attn_load_e<NT>(ks + 3, kbase, vbase, L16, rb, i0, lane);
  }
#pragma unroll 1
  for (int kk = 0; kk < 5; ++kk) {
    int e0 = 18 + NT * kk, ks = 18 + kk;
#pragma unroll
    for (int t = 0; t < NT; t += 2) {
      attn_step(ks, bA, L16, rb + RS * t, i0, iq, lane, qs + t * 128, o[t], mrun[t], lrun[t]);
      bA = attn_load_e<NT>(min(e0 + t + 2, EMAX), kbase, vbase, L16, rb, i0, lane);
      attn_step(ks, bB, L16, rb + RS * (t + 1), i0, iq, lane, qs + (t + 1) * 128, o[t + 1], mrun[t + 1], lrun[t + 1]);
      bB = attn_load_e<NT>(min(e0 + t + 3, EMAX), kbase, vbase, L16, rb, i0, lane);
    }
  }
  u16* omix = (u16*)(p.ws + OFF_OMIX);
#pragma unroll
  for (int t = 0; t < NT; ++t) {
    float l = lrun[t];
    l += __shfl_xor(l, 16);
    l += __shfl_xor(l, 32);
    float inv = 1.f / l;
    u16* op = omix + (size_t)(seq0 + rb + RS * t + 16 * iq) * 1024 + h * 64 + quad * 4;
#pragma unroll
    for (int dt = 0; dt < 4; ++dt) {
      uint2 w; w.x = pack2(o[t][dt][0] * inv, o[t][dt][1] * inv); w.y = pack2(o[t][dt][2] * inv, o[t][dt][3] * inv);
      *(uint2*)(op + dt * 16) = w;
    }
  }
}

constexpr int ATT_NT = 4;
__device__ void phase_attn(const P& p) {
  int wid = __builtin_amdgcn_readfirstlane(opaque_tid(p) >> 6);
  for (int u = blockIdx.x * 8 + wid; u < 32768 / ATT_NT; u += gridDim.x * 8) attn_unitN<ATT_NT>(p, u);
}

constexpr int LP = 72;
constexpr int G_BF = 0;
constexpr int G_BB = G_BF + 64 * 65 * 4;
constexpr int G_T0 = G_BB + 64 * 65 * 4;
constexpr int G_T1 = G_T0 + 64 * LP * 2;
constexpr int G_T2 = G_T1 + 64 * LP * 2;
constexpr int G_T3 = G_T2 + 64 * LP * 2;
constexpr int G_VT = G_T3 + 64 * LP * 2;
constexpr int G_ATT = G_VT + 128 * LP * 2;
constexpr int G_SSQ = G_ATT + 64 * LP * 2;
constexpr int G_SEG = G_SSQ + 512;

#define LBAR do { asm volatile("s_waitcnt lgkmcnt(0)" ::: "memory"); __builtin_amdgcn_s_barrier(); } while (0)
__device__ __forceinline__ void gla_cumsum(const P& p, uint4 a, uint4 b, char* sm) {
  float* bF = (float*)(sm + G_BF);
  float* bB = (float*)(sm + G_BB);
  int tid = opaque_tid(p);
  {
    int s = tid >> 3, d0 = (tid & 7) * 8;
    const u16* pa = (const u16*)&a; const u16* pb = (const u16*)&b;
#pragma unroll
    for (int e = 0; e < 8; ++e) { bF[s * 65 + d0 + e] = bf2f(pa[e]); bB[s * 65 + d0 + e] = bf2f(pb[e]); }
  }
  LBAR;
  {
    float* segF = (float*)(sm + G_SEG);
    float* segB = segF + 8 * 64;
    int dk = tid & 63, seg = tid >> 6;
    float a = 0.f, c = 0.f;
#pragma unroll
    for (int i = 0; i < 8; ++i) { a += bF[(seg * 8 + i) * 65 + dk]; bF[(seg * 8 + i) * 65 + dk] = a; }
#pragma unroll
    for (int i = 7; i >= 0; --i) { c += bB[(seg * 8 + i) * 65 + dk]; bB[(seg * 8 + i) * 65 + dk] = c; }
    segF[seg * 64 + dk] = a; segB[seg * 64 + dk] = c;
    LBAR;
    float offF = 0.f, offB = 0.f;
#pragma unroll
    for (int s2 = 0; s2 < 8; ++s2) {
      float f = segF[s2 * 64 + dk], g = segB[s2 * 64 + dk];
      offF += (s2 < seg) ? f : 0.f;
      offB += (s2 > seg) ? g : 0.f;
    }
#pragma unroll
    for (int i = 0; i < 8; ++i) { bF[(seg * 8 + i) * 65 + dk] += offF; bB[(seg * 8 + i) * 65 + dk] += offB; }
  }
  LBAR;
}

struct SummRaw { uint4 laf, lab, k, v0, v1; };
__device__ __forceinline__ SummRaw gla_summ_load(const P& p, int unit, int tid) {
  SummRaw r;
  int chunk = unit >> 2, h = unit & 3;
  { int s = tid >> 3, d0 = (tid & 7) * 8;
    size_t g = (size_t)(chunk * 64 + s) * 256 + h * 64 + d0;
    r.laf = *(const uint4*)((const u16*)(p.ws + OFF_LAF) + g);
    r.lab = *(const uint4*)((const u16*)(p.ws + OFF_LAB) + g); }
  { int s = tid & 63, dg = tid >> 6;
    r.k = *(const uint4*)((const u16*)(p.ws + OFF_KA) + (size_t)(chunk * 64 + s) * 256 + h * 64 + dg * 8); }
  const u16* vsrc = (const u16*)(p.ws + OFF_VAT) + (size_t)unit * 8192;
  r.v0 = *(const uint4*)(vsrc + (tid >> 3) * 64 + (tid & 7) * 8);
  r.v1 = *(const uint4*)(vsrc + ((tid + 512) >> 3) * 64 + (tid & 7) * 8);
  return r;
}

__device__ __forceinline__ void gla_summ_unit(const P& p, int unit, const SummRaw& raw) {
  extern __shared__ __attribute__((aligned(16))) u16 shm[];
  char* sm = (char*)shm;
  int tid = opaque_tid(p), lane = tid & 63, wid = tid >> 6;
  gla_cumsum(p, raw.laf, raw.lab, sm);
  float* bF = (float*)(sm + G_BF);
  float* bB = (float*)(sm + G_BB);
  u16* kdfT = (u16*)(sm + G_T0);
  u16* kdbT = (u16*)(sm + G_T1);
  u16* vT = (u16*)(sm + G_VT);
  {
    int s = tid & 63, dg = tid >> 6;
    const u16* pk = (const u16*)&raw.k;
#pragma unroll
    for (int e = 0; e < 8; ++e) {
      int dk = dg * 8 + e;
      float k = bf2f(pk[e]);
      kdfT[dk * LP + s] = f2bf(k * __expf(bF[63 * 65 + dk] - bF[s * 65 + dk]));
      kdbT[dk * LP + s] = f2bf(k * __expf(bB[0 * 65 + dk] - bB[s * 65 + dk]));
    }
    *(uint4*)(vT + (tid >> 3) * LP + (tid & 7) * 8) = raw.v0;
    *(uint4*)(vT + ((tid + 512) >> 3) * LP + (tid & 7) * 8) = raw.v1;
    if (tid < 128) {
      int dir = tid >> 6, dk = tid & 63;
      float* dec = (float*)(p.ws + OFF_DEC);
      dec[(size_t)(unit * 2 + dir) * 64 + dk] = __expf(dir == 0 ? bF[63 * 65 + dk] : bB[dk]);
    }
  }
  LBAR;
  u16* kvout = (u16*)((char*)p.out + OUT_KV);
  int fr = lane & 15, fq = lane >> 4;
#pragma unroll 1
  for (int tI = 0; tI < 8; ++tI) {
    int tile = wid * 8 + tI;
    int dir = tile >> 5, dkt = (tile >> 3) & 3, dvt = tile & 7;
    const u16* Asrc = (dir ? kdbT : kdfT) + (dkt * 16 + fr) * LP + fq * 8;
    const u16* Bsrc = vT + (dvt * 16 + fr) * LP + fq * 8;
    f32x4 d = {0.f, 0.f, 0.f, 0.f};
#pragma unroll
    for (int ks = 0; ks < 2; ++ks) {
      bf16x8 a = *(const bf16x8*)(Asrc + ks * 32);
      bf16x8 b = *(const bf16x8*)(Bsrc + ks * 32);
      d = __builtin_amdgcn_mfma_f32_16x16x32_bf16(a, b, d, 0, 0, 0);
    }
    uint2 w; w.x = pack2(d[0], d[1]); w.y = pack2(d[2], d[3]);
    *(uint2*)(kvout + (size_t)(unit * 2 + dir) * 8192 + (dvt * 16 + fr) * 64 + dkt * 16 + fq * 4) = w;
  }
  LBAR;
}

__device__ void phase_gla_summ(const P& p) {
  int tid = opaque_tid(p);
  int u = blockIdx.x;
  if (u >= 4096) return;
  SummRaw cur = gla_summ_load(p, u, tid);
  for (; u < 4096; u += gridDim.x) {
    int un = u + gridDim.x;
    SummRaw nxt = gla_summ_load(p, un < 4096 ? un : u, tid);
    gla_summ_unit(p, u, cur);
    cur = nxt;
  }
}

__device__ void phase_gla_scan(const P& p) {
  u16* kv = (u16*)((char*)p.out + OUT_KV);
  const float* dec = (const float*)(p.ws + OFF_DEC);
  int tid = opaque_tid(p);
  for (int it = blockIdx.x; it < 768; it += gridDim.x) {
    int chunk0, nc, q;
    if (it < 256) { q = it; int seq = q >> 6; chunk0 = 512 + seq * 128; nc = 128; q &= 63; }
    else { q = it - 256; int seq = q >> 6; chunk0 = seq * 64; nc = 64; q &= 63; }
    int h = q >> 4, dir = (q >> 3) & 1, sl = q & 7;
    int e0 = sl * 1024 + tid * 2;
    int dk = e0 & 63;
    float s0 = 0.f, s1 = 0.f;
    for (int n8 = 0; n8 < nc; n8 += 8) {
      unsigned kvv[8]; float2 dd[8];
#pragma unroll
      for (int i = 0; i < 8; ++i) {
        int n = n8 + i;
        int chunk = dir == 0 ? chunk0 + n : chunk0 + nc - 1 - n;
        size_t base = (size_t)((chunk * 4 + h) * 2 + dir);
        kvv[i] = *(const unsigned*)(kv + base * 8192 + e0);
        dd[i] = *(const float2*)(dec + base * 64 + dk);
      }
#pragma unroll
      for (int i = 0; i < 8; ++i) {
        int n = n8 + i;
        int chunk = dir == 0 ? chunk0 + n : chunk0 + nc - 1 - n;
        size_t base = (size_t)((chunk * 4 + h) * 2 + dir);
        *(unsigned*)(kv + base * 8192 + e0) = pack2(s0, s1);
        s0 = dd[i].x * s0 + bf2f((u16)(kvv[i] & 0xffff));
        s1 = dd[i].y * s1 + bf2f((u16)(kvv[i] >> 16));
      }
    }
  }
}

struct OutRaw { uint4 laf, lab, q, k, v0, v1; };
__device__ __forceinline__ OutRaw gla_out_load(const P& p, int unit, int tid) {
  OutRaw r;
  int chunk = unit >> 2, h = unit & 3;
  int s = tid >> 3, d0 = (tid & 7) * 8;
  size_t g = (size_t)(chunk * 64 + s) * 256 + h * 64 + d0;
  r.laf = *(const uint4*)((const u16*)(p.ws + OFF_LAF) + g);
  r.lab = *(const uint4*)((const u16*)(p.ws + OFF_LAB) + g);
  r.q = *(const uint4*)((const u16*)(p.ws + OFF_QA) + g);
  r.k = *(const uint4*)((const u16*)(p.ws + OFF_KA) + g);
  const u16* vsrc = (const u16*)(p.ws + OFF_VAT) + (size_t)unit * 8192;
  r.v0 = *(const uint4*)(vsrc + (tid >> 3) * 64 + (tid & 7) * 8);
  r.v1 = *(const uint4*)(vsrc + ((tid + 512) >> 3) * 64 + (tid & 7) * 8);
  return r;
}

__device__ __forceinline__ void gla_out_unit(const P& p, int unit, const OutRaw& raw) {
  extern __shared__ __attribute__((aligned(16))) u16 shm[];
  char* sm = (char*)shm;
  int chunk = unit >> 2, h = unit & 3;
  int tid = opaque_tid(p), lane = tid & 63, wid = tid >> 6;
  bf16x8 sB[4][2][2];
  uint2 rav[4];
  {
    int fr = lane & 15, fq = lane >> 4, tt = wid >> 1, dvh = wid & 1;
    const u16* Sst = (const u16*)((const char*)p.out + OUT_KV) + (size_t)(unit * 2) * 8192;
    const u16* ra = (const u16*)(p.ws + OFF_RA);
#pragma unroll
    for (int i = 0; i < 4; ++i) {
      int dvt = dvh * 4 + i;
#pragma unroll
      for (int ks = 0; ks < 2; ++ks) {
        sB[i][ks][0] = *(const bf16x8*)(Sst + (dvt * 16 + fr) * 64 + ks * 32 + fq * 8);
        sB[i][ks][1] = *(const bf16x8*)(Sst + 8192 + (dvt * 16 + fr) * 64 + ks * 32 + fq * 8);
      }
      rav[i] = *(const uint2*)(ra + ((size_t)unit * 128 + dvt * 16 + fr) * 64 + tt * 16 + fq * 4);
    }
  }
  gla_cumsum(p, raw.laf, raw.lab, sm);
  float* bF = (float*)(sm + G_BF);
  float* bB = (float*)(sm + G_BB);
  u16* qf = (u16*)(sm + G_T0);
  u16* qb = (u16*)(sm + G_T1);
  u16* kf = (u16*)(sm + G_T2);
  u16* kb = (u16*)(sm + G_T3);
  u16* vT = (u16*)(sm + G_VT);
  u16* att = (u16*)(sm + G_ATT);
  float* ssq = (float*)(sm + G_SSQ);
  {
    int s = tid >> 3, d0 = (tid & 7) * 8;
    const u16* pq = (const u16*)&raw.q; const u16* pk = (const u16*)&raw.k;
    u16 oqf[8], oqb[8], okf[8], okb[8];
#pragma unroll
    for (int e = 0; e < 8; ++e) {
      float bf = bF[s * 65 + d0 + e], bb = bB[s * 65 + d0 + e];
      float qq = bf2f(pq[e]), kk = bf2f(pk[e]);
      oqf[e] = f2bf(qq * __expf(bf)); oqb[e] = f2bf(qq * __expf(bb));
      okf[e] = f2bf(kk * __expf(-bf)); okb[e] = f2bf(kk * __expf(-bb));
    }
    *(uint4*)(qf + s * LP + d0) = *(const uint4*)oqf;
    *(uint4*)(qb + s * LP + d0) = *(const uint4*)oqb;
    *(uint4*)(kf + s * LP + d0) = *(const uint4*)okf;
    *(uint4*)(kb + s * LP + d0) = *(const uint4*)okb;
    *(uint4*)(vT + (tid >> 3) * LP + (tid & 7) * 8) = raw.v0;
    *(uint4*)(vT + ((tid + 512) >> 3) * LP + (tid & 7) * 8) = raw.v1;
  }
  LBAR;
  int fr = lane & 15, fq = lane >> 4;
#pragma unroll 1
  for (int tI = 0; tI < 2; ++tI) {
    int tile = wid * 2 + tI; int tt = tile >> 2, st = tile & 3;
    f32x4 df = {0.f, 0.f, 0.f, 0.f}, db = {0.f, 0.f, 0.f, 0.f};
#pragma unroll
    for (int ks = 0; ks < 2; ++ks) {
      bf16x8 a = *(const bf16x8*)(qf + (tt * 16 + fr) * LP + ks * 32 + fq * 8);
      bf16x8 b = *(const bf16x8*)(kf + (st * 16 + fr) * LP + ks * 32 + fq * 8);
      df = __builtin_amdgcn_mfma_f32_16x16x32_bf16(a, b, df, 0, 0, 0);
      bf16x8 a2 = *(const bf16x8*)(qb + (tt * 16 + fr) * LP + ks * 32 + fq * 8);
      bf16x8 b2 = *(const bf16x8*)(kb + (st * 16 + fr) * LP + ks * 32 + fq * 8);
      db = __builtin_amdgcn_mfma_f32_16x16x32_bf16(a2, b2, db, 0, 0, 0);
    }
    int s = st * 16 + fr;
#pragma unroll
    for (int j = 0; j < 4; ++j) {
      int t = tt * 16 + fq * 4 + j;
      float v = (s <= t) ? df[j] : db[j];
      att[t * LP + s] = f2bf(v);
    }
  }
  LBAR;
  int tt = wid >> 1, dvh = wid & 1;
  f32x4 o[4];
  float sq[4] = {0.f, 0.f, 0.f, 0.f};
#pragma unroll
  for (int i = 0; i < 4; ++i) {
    int dvt = dvh * 4 + i;
    f32x4 d = {0.f, 0.f, 0.f, 0.f};
#pragma unroll
    for (int ks = 0; ks < 2; ++ks) {
      bf16x8 a = *(const bf16x8*)(att + (tt * 16 + fr) * LP + ks * 32 + fq * 8);
      bf16x8 b = *(const bf16x8*)(vT + (dvt * 16 + fr) * LP + ks * 32 + fq * 8);
      d = __builtin_amdgcn_mfma_f32_16x16x32_bf16(a, b, d, 0, 0, 0);
      bf16x8 a1 = *(const bf16x8*)(qf + (tt * 16 + fr) * LP + ks * 32 + fq * 8);
      bf16x8 b1 = sB[i][ks][0];
      d = __builtin_amdgcn_mfma_f32_16x16x32_bf16(a1, b1, d, 0, 0, 0);
      bf16x8 a2 = *(const bf16x8*)(qb + (tt * 16 + fr) * LP + ks * 32 + fq * 8);
      bf16x8 b2 = sB[i][ks][1];
      d = __builtin_amdgcn_mfma_f32_16x16x32_bf16(a2, b2, d, 0, 0, 0);
    }
    o[i] = d;
#pragma unroll
    for (int j = 0; j < 4; ++j) sq[j] += d[j] * d[j];
  }
#pragma unroll
  for (int j = 0; j < 4; ++j) {
    float v = sq[j];
    v = row16_sum(v);
    sq[j] = v;
  }
  if (fr == 0) {
#pragma unroll
    for (int j = 0; j < 4; ++j) ssq[(tt * 16 + fq * 4 + j) * 2 + dvh] = sq[j];
  }
  LBAR;
  u16* omix = (u16*)(p.ws + OFF_OMIX);
  {
    float rsj[4];
#pragma unroll
    for (int j = 0; j < 4; ++j) {
      int t = tt * 16 + fq * 4 + j;
      float tot = ssq[t * 2] + ssq[t * 2 + 1];
      rsj[j] = rsqrtf(tot * (1.f / 128.f) + 1e-6f);
    }
    int row0 = chunk * 64 + tt * 16 + fq * 4;
#pragma unroll
    for (int i = 0; i < 4; ++i) {
      int dv = (dvh * 4 + i) * 16 + fr;
      float g = p.g_gla[dv];
      float s0 = __uint_as_float(rav[i].x << 16), s1 = __uint_as_float(rav[i].x & 0xffff0000u);
      float s2 = __uint_as_float(rav[i].y << 16), s3 = __uint_as_float(rav[i].y & 0xffff0000u);
      store_rm4(omix, 1024, row0, 512 + h * 128 + dv, o[i][0] * rsj[0] * g * s0, o[i][1] * rsj[1] * g * s1,
                o[i][2] * rsj[2] * g * s2, o[i][3] * rsj[3] * g * s3, fr & 1);
    }
  }
  LBAR;
}

__device__ void phase_gla_out(const P& p) {
  int tid = opaque_tid(p);
  int u = blockIdx.x;
  if (u >= 4096) return;
  OutRaw cur = gla_out_load(p, u, tid);
  for (; u < 4096; u += gridDim.x) {
    int un = u + gridDim.x;
    OutRaw nxt = gla_out_load(p, un < 4096 ? un : u, tid);
    gla_out_unit(p, u, cur);
    cur = nxt;
  }
}

__device__ __forceinline__ void ssq_store(float (&sq)[2][4][4], float* dstbase, int brow, int slot, int wr, int fr, int fq) {
#pragma unroll
  for (int ai = 0; ai < 2; ++ai)
#pragma unroll
    for (int m = 0; m < 4; ++m)
#pragma unroll
      for (int j = 0; j < 4; ++j) {
        float v = sq[ai][m][j];
        v = row16_sum(v);
        if (fr == 0) dstbase[(size_t)(brow + ai * 128 + wr * 64 + m * 16 + fq * 4 + j) * 16 + slot] = v;
      }
}

struct EpiOut {
  P p; static constexpr bool twice = false;
  __device__ __forceinline__ void operator()(f32x4 (&acc)[2][2][4][2], int brow, int bcol, int wr, int wc, int fr, int fq) const {
    u16* x1b = (u16*)(p.ws + OFF_X1B);
    float* ssq1 = (float*)(p.ws + OFF_SSQ1);
    int slot = (bcol >> 8) * 4 + wc;
    const bool odd = fr & 1;
    const int o1 = odd ? 1 : 0;
    float2 tc[4][2], tn[4][2];
    {
      const float* xb0 = xrow(p, brow + wr * 64 + fq * 4);
#pragma unroll
      for (int q = 0; q < 4; ++q)
#pragma unroll
        for (int pr = 0; pr < 2; ++pr)
          tc[q][pr] = *(const float2*)(xb0 + (size_t)(2 * pr + o1) * 1024 + (bcol + (q >> 1) * 128 + wc * 32 + (q & 1) * 16 + fr - o1));
    }
#pragma unroll
    for (int ch = 0; ch < 8; ++ch) {
      const int ai = ch >> 2, m = ch & 3;
      int row0 = brow + ai * 128 + wr * 64 + m * 16 + fq * 4;
      if (ch + 1 < 8) {
        const float* xbn = xrow(p, brow + ((ch + 1) >> 2) * 128 + wr * 64 + ((ch + 1) & 3) * 16 + fq * 4);
#pragma unroll
        for (int q = 0; q < 4; ++q)
#pragma unroll
          for (int pr = 0; pr < 2; ++pr)
            tn[q][pr] = *(const float2*)(xbn + (size_t)(2 * pr + o1) * 1024 + (bcol + (q >> 1) * 128 + wc * 32 + (q & 1) * 16 + fr - o1));
      }
      __builtin_amdgcn_sched_barrier(0);
      float sq[4] = {0.f, 0.f, 0.f, 0.f};
#pragma unroll
      for (int q = 0; q < 4; ++q) {
        const int bj = q >> 1, n = q & 1;
        int c = bcol + bj * 128 + wc * 32 + n * 16 + fr;
        float v[4];
#pragma unroll
        for (int pr = 0; pr < 2; ++pr) {
          float2 t = tc[q][pr];
          float r = dpp_swap1(odd ? t.x : t.y);
          v[2 * pr] = odd ? r : t.x; v[2 * pr + 1] = odd ? t.y : r;
        }
#pragma unroll
        for (int j = 0; j < 4; ++j) { v[j] += acc[ai][bj][m][n][j]; sq[j] += v[j] * v[j]; }
        store_rm4(x1b, 1024, row0, c, v[0], v[1], v[2], v[3], odd);
      }
#pragma unroll
      for (int j = 0; j < 4; ++j) {
        float t = row16_sum(sq[j]);
        if (fr == 0) ssq1[(size_t)(row0 + j) * 16 + slot] = t;
      }
      __builtin_amdgcn_sched_barrier(0);
#pragma unroll
      for (int q = 0; q < 4; ++q) { tc[q][0] = tn[q][0]; tc[q][1] = tn[q][1]; }
    }
  }
};

struct EpiGU {
  P p; static constexpr bool twice = false;
  __device__ __forceinline__ void operator()(f32x4 (&acc)[2][2][4][2], int brow, int bcol, int wr, int wc, int fr, int fq) const {
    const float* ssq1 = (const float*)(p.ws + OFF_SSQ1);
    u16* act = (u16*)(p.ws + OFF_ACT);
    int t = bcol >> 8;
    float sv[2][4][4];
#pragma unroll
    for (int ai = 0; ai < 2; ++ai)
#pragma unroll
      for (int m = 0; m < 4; ++m)
#pragma unroll
        for (int j = 0; j < 4; ++j) sv[ai][m][j] = ssq1[(size_t)(brow + ai * 128 + wr * 64 + m * 16 + fq * 4 + j) * 16 + fr];
    __builtin_amdgcn_sched_barrier(0);
#pragma unroll
    for (int ai = 0; ai < 2; ++ai)
#pragma unroll
      for (int m = 0; m < 4; ++m) {
        int row0 = brow + ai * 128 + wr * 64 + m * 16 + fq * 4;
        float rs[4];
#pragma unroll
        for (int j = 0; j < 4; ++j) rs[j] = rsqrtf(row16_sum(sv[ai][m][j]) * (1.f / 1024.f) + 1e-6f);
#pragma unroll
        for (int n = 0; n < 2; ++n) {
          float a[4];
#pragma unroll
          for (int j = 0; j < 4; ++j) {
            float g = acc[ai][0][m][n][j] * rs[j], u = acc[ai][1][m][n][j] * rs[j];
            a[j] = fast_silu(g) * u;
          }
          store_rm4(act, 2816, row0, t * 128 + wc * 32 + n * 16 + fr, a[0], a[1], a[2], a[3], fr & 1);
        }
        __builtin_amdgcn_sched_barrier(0);
      }
  }
};

struct EpiDown {
  P p;
  __device__ __forceinline__ void operator()(f32x4 (&acc)[2][2][4][2], int brow, int bcol, int wr, int wc, int fr, int fq) const {
    const u16* x1b = (const u16*)(p.ws + OFF_X1B);
    float sq[2][4][4];
#pragma unroll
    for (int ai = 0; ai < 2; ++ai)
#pragma unroll
      for (int m = 0; m < 4; ++m) {
        int row0 = brow + ai * 128 + wr * 64 + m * 16 + fq * 4;
#pragma unroll
        for (int j = 0; j < 4; ++j) {
          float s = 0.f;
#pragma unroll
          for (int bj = 0; bj < 2; ++bj)
#pragma unroll
            for (int n = 0; n < 2; ++n) {
              int c = bcol + bj * 128 + wc * 32 + n * 16 + fr;
              size_t o = (size_t)(row0 + j) * 1024 + c;
              float v = bf2f(x1b[o]) + acc[ai][bj][m][n][j];
              p.out[o] = v;
              s += v * v;
            }
          sq[ai][m][j] = s;
        }
      }
    ssq_store(sq, (float*)(p.ws + OFF_SSQ2), brow, (bcol >> 8) * 4 + wc, wr, fr, fq);
  }
};

struct EpiDownF {
  P p; static constexpr bool twice = false;
  __device__ __forceinline__ void operator()(f32x4 (&acc)[2][2][4][2], int brow, int bcol, int wr, int wc, int fr, int fq) const {
    extern __shared__ __attribute__((aligned(16))) u16 shm[];
    float* part = (float*)((char*)shm + 3 * HT * 2);
    float* rsl = part + 1024;
    const u16* x1b = (const u16*)(p.ws + OFF_X1B);
    unsigned long long* gran = (unsigned long long*)(p.ws + OFF_SSQ2);
    int ntile = bcol >> 8;
    int tid = (wr * 4 + wc) * 64 + fq * 16 + fr;
#pragma unroll
    for (int ai = 0; ai < 2; ++ai)
#pragma unroll
      for (int m = 0; m < 4; ++m) {
        int rl0 = ai * 128 + wr * 64 + m * 16 + fq * 4;
        float sq[4] = {0.f, 0.f, 0.f, 0.f};
#pragma unroll
        for (int bj = 0; bj < 2; ++bj)
#pragma unroll
          for (int n = 0; n < 2; ++n) {
            int c = bcol + bj * 128 + wc * 32 + n * 16 + fr;
            float xv[4];
            load_rm4_bf16(x1b + (size_t)(brow + rl0) * 1024, 1024, c, fr & 1, xv);
#pragma unroll
            for (int j = 0; j < 4; ++j) {
              float v = xv[j] + acc[ai][bj][m][n][j];
              acc[ai][bj][m][n][j] = v;
              sq[j] += v * v;
            }
          }
#pragma unroll
        for (int j = 0; j < 4; ++j) {
          float s = sq[j];
          s = row16_sum(s);
          if (fr == 0) part[(rl0 + j) * 4 + wc] = s;
        }
        __builtin_amdgcn_sched_barrier(0);
      }
    __syncthreads();
    if (tid < 256) {
      float s = part[tid * 4] + part[tid * 4 + 1] + part[tid * 4 + 2] + part[tid * 4 + 3];
      unsigned long long g = (unsigned long long)__float_as_uint(s) | (1ull << 32);
      __hip_atomic_store(gran + (size_t)(brow + tid) * 4 + ntile, g, __ATOMIC_RELAXED, __HIP_MEMORY_SCOPE_AGENT);
    }
    asm volatile("s_waitcnt vmcnt(0)" ::: "memory");
    __syncthreads();
    unsigned* cnt = (unsigned*)(p.ws + OFF_CNT) + (brow >> 8);
    if (tid == 0) {
      __hip_atomic_fetch_add(cnt, 1u, __ATOMIC_RELAXED, __HIP_MEMORY_SCOPE_AGENT);
      while (__hip_atomic_load(cnt, __ATOMIC_RELAXED, __HIP_MEMORY_SCOPE_AGENT) < 4u) __builtin_amdgcn_s_sleep(2);
    }
    __syncthreads();
    if (tid < 256) {
      float tot = 0.f;
#pragma unroll
      for (int q = 0; q < 4; ++q) {
        unsigned long long g;
        do { g = __hip_atomic_load(gran + (size_t)(brow + tid) * 4 + q, __ATOMIC_RELAXED, __HIP_MEMORY_SCOPE_AGENT); } while ((unsigned)(g >> 32) != 1u);
        tot += __uint_as_float((unsigned)g);
      }
      rsl[tid] = rsqrtf(tot * (1.f / 1024.f) + 1e-6f);
    }
    __syncthreads();
#pragma unroll
    for (int ai = 0; ai < 2; ++ai)
#pragma unroll
      for (int m = 0; m < 4; ++m) {
        int rl0 = ai * 128 + wr * 64 + m * 16 + fq * 4;
        float4 r4 = *(const float4*)(rsl + rl0);
        float rr[4] = {r4.x, r4.y, r4.z, r4.w};
#pragma unroll
        for (int bj = 0; bj < 2; ++bj)
#pragma unroll
          for (int n = 0; n < 2; ++n) {
            int c = bcol + bj * 128 + wc * 32 + n * 16 + fr;
            float gf = p.g_final[c];
            store_rm4_f32(p.out + (size_t)(brow + rl0) * 1024, 1024, c, fr & 1, acc[ai][bj][m][n][0] * rr[0] * gf,
                          acc[ai][bj][m][n][1] * rr[1] * gf, acc[ai][bj][m][n][2] * rr[2] * gf, acc[ai][bj][m][n][3] * rr[3] * gf);
          }
        __builtin_amdgcn_sched_barrier(0);
      }
  }
};

__device__ void phase_final(const P& p) {
  int tid = opaque_tid(p); int lane = tid & 63, wid = tid >> 6;
  const float* ssq2 = (const float*)(p.ws + OFF_SSQ2);
  for (int row = blockIdx.x * 8 + wid; row < NTOK; row += gridDim.x * 8) {
    float v = ssq2[(size_t)row * 16 + (lane & 15)];
    v = row16_sum(v);
    float rs = rsqrtf(v * (1.f / 1024.f) + 1e-6f);
    float4* o = (float4*)(p.out + (size_t)row * 1024);
    const float4* g = (const float4*)p.g_final;
#pragma unroll
    for (int i = 0; i < 4; ++i) {
      float4 x = o[lane + i * 64], gg = g[lane + i * 64];
      x.x *= rs * gg.x; x.y *= rs * gg.y; x.z *= rs * gg.z; x.w *= rs * gg.w;
      o[lane + i * 64] = x;
    }
  }
}

#define XB_TMO      128
#define XB_XCNT(j)  (256  + 64 * (j))
#define XB_XSUB(j)  (1280 + 64 * (j))
#define XB_XGEN(j)  (2304 + 64 * (j))
#define XB_TOP      3328
#define XB_TOPGEN   3392
#define XCD_BAR_WORDS 3456
#define XB_SPIN_CAP (1u << 18)
#define LAS __attribute__((address_space(3)))
__device__ __forceinline__ unsigned xb_ld(unsigned* q)              { return __hip_atomic_load(q, __ATOMIC_RELAXED, __HIP_MEMORY_SCOPE_AGENT); }
__device__ __forceinline__ unsigned xb_add(unsigned* q, unsigned v) { return __hip_atomic_fetch_add(q, v, __ATOMIC_RELAXED, __HIP_MEMORY_SCOPE_AGENT); }
__device__ __forceinline__ unsigned xb_xcc_id() { return (unsigned)__builtin_amdgcn_s_getreg((3 << 11) | 20) & 0xFu; }
#define XB_SPIN(cond, bar) do { unsigned _sp = 0; while (cond) { __builtin_amdgcn_s_sleep(1); \
    if ((++_sp & 255u) == 0u) { if (xb_ld(&(bar)[XB_TMO])) break; if (_sp > XB_SPIN_CAP) { atomicAdd(&(bar)[XB_TMO], 1u); break; } } } } while (0)
struct XcdBarrier { unsigned* bar; unsigned x; volatile LAS unsigned* st; };

__device__ __forceinline__ void xcd_barrier_complete(unsigned* bar, unsigned x, unsigned& nloc, unsigned& nx) {
  const unsigned G = gridDim.x * gridDim.y * gridDim.z;
  unsigned sum, cnt, mine, sp = 0u;
  for (;;) {
    sum = 0u; cnt = 0u; mine = 0u;
#pragma unroll
    for (unsigned j = 0; j < 16; ++j) { const unsigned c = xb_ld(&bar[XB_XCNT(j)]); sum += c; cnt += (c > 0u) ? 1u : 0u; mine = (j == x) ? c : mine; }
    if (sum == G) break;
    __builtin_amdgcn_s_sleep(1);
    if ((++sp & 255u) == 0u) { if (xb_ld(&bar[XB_TMO])) break; if (sp > XB_SPIN_CAP) { atomicAdd(&bar[XB_TMO], 1u); break; } }
  }
  nloc = mine > 0u ? mine : 1u; nx = cnt > 0u ? cnt : 1u;
}

__device__ __forceinline__ void xcd_barrier(const XcdBarrier& b, const P& p) {
  asm volatile("s_waitcnt vmcnt(0)" ::: "memory");
  __syncthreads();
  if (opaque_tid(p) == 0) {
    unsigned* bar = b.bar;
    __builtin_amdgcn_s_waitcnt(0);
    unsigned nloc = b.st[0], nx = b.st[1];
    if (nloc == 0u) { xcd_barrier_complete(bar, b.x, nloc, nx); b.st[0] = nloc; b.st[1] = nx; }
    const unsigned old = xb_add(&bar[XB_XSUB(b.x)], 1u);
    const unsigned gen = old / nloc;
    if (old + 1u == (gen + 1u) * nloc) {
      __builtin_amdgcn_fence(__ATOMIC_RELEASE, "agent");
      asm volatile("s_waitcnt vmcnt(0)" ::: "memory");
      const unsigned og = xb_add(&bar[XB_TOP], 1u);
      const unsigned tg = og / nx;
      if (og + 1u == (tg + 1u) * nx) xb_add(&bar[XB_TOPGEN], 1u);
      else XB_SPIN(xb_ld(&bar[XB_TOPGEN]) == tg, bar);
      __builtin_amdgcn_fence(__ATOMIC_ACQUIRE, "agent");
      xb_add(&bar[XB_XGEN(b.x)], 1u);
      asm volatile("s_waitcnt vmcnt(0)" ::: "memory");
    } else {
      XB_SPIN(xb_ld(&bar[XB_XGEN(b.x)]) == gen, bar);
      __builtin_amdgcn_fence(__ATOMIC_ACQUIRE, "agent");
      asm volatile("s_waitcnt vmcnt(0)" ::: "memory");
    }
  }
  __syncthreads();
}

__device__ __forceinline__ void run_phase(const P& p, int ph) {
  switch (ph) {
    case 0: phase_prep(p); break;
    case 1: gemm_phase((const u16*)(p.ws + OFF_XB), (const u16*)(p.ws + OFF_WIN), 1024, 13, EpiIn{p}); break;
    case 2: phase_gla_summ(p); phase_attn(p); break;
    case 3: phase_gla_scan(p); break;
    case 4: phase_gla_out(p); break;
    case 5: gemm_phase((const u16*)(p.ws + OFF_OMIX), (const u16*)(p.ws + OFF_WOUT), 1024, 4, EpiOut{p}); break;
    case 6: gemm_phase((const u16*)(p.ws + OFF_X1B), (const u16*)(p.ws + OFF_WGU), 1024, 22, EpiGU{p}); break;
#if MEGA && FUSE_FINAL
    case 7: gemm_phase((const u16*)(p.ws + OFF_ACT), (const u16*)(p.ws + OFF_WDN), 2816, 4, EpiDownF{p}); break;
    case 8: break;
#else
    case 7: gemm_phase((const u16*)(p.ws + OFF_ACT), (const u16*)(p.ws + OFF_WDN), 2816, 4, EpiDown{p}); break;
    case 8: phase_final(p); break;
#endif
    case 9: phase_attn(p); break;
    case 10: phase_gla_summ(p); break;
  }
}

#if MEGA
__global__ void __launch_bounds__(512) fwd_mega(P pin) {
  cg::grid_group grid = cg::this_grid();
  P p = pin; p.wv = __builtin_amdgcn_readfirstlane((int)(threadIdx.x >> 6));
  __shared__ uint4 xb_words;
  if (threadIdx.x == 0) {
    xb_words = make_uint4(0u, 0u, 0u, 0u);
  }
  __syncthreads();
  XcdBarrier xb;
  xb.bar = (unsigned*)(p.ws + OFF_BAR); xb.x = xb_xcc_id(); xb.st = (volatile LAS unsigned*)&xb_words;
  if (blockIdx.x == 0) for (int i = threadIdx.x; i < XCD_BAR_WORDS; i += 512) xb.bar[i] = 0u;
  p.vx = __builtin_amdgcn_readfirstlane((int)(blockIdx.x & 7)); p.vj = __builtin_amdgcn_readfirstlane((int)(blockIdx.x >> 3));
  grid.sync();
  if (threadIdx.x == 0) xb_words.z = xb_add(&xb.bar[XB_XCNT(xb.x)], 1u);
  run_phase(p, 0); xcd_barrier(xb, p);
  {
    if (opaque_tid(p) == 0) {
      bool ok = true;
#pragma unroll
      for (unsigned j = 0; j < 16; ++j) { unsigned c = xb_ld(&xb.bar[XB_XCNT(j)]); ok = ok && (c == (j < 8 ? 32u : 0u)); }
      xb_words.w = ok ? 1u : 0u;
    }
    __syncthreads();
    {
      int okf = __builtin_amdgcn_readfirstlane((int)xb_words.w);
      int zj = __builtin_amdgcn_readfirstlane((int)xb_words.z);
      bool use = okf != 0 && xb.x < 8u;
      int nvx = use ? (int)xb.x : p.vx, nvj = use ? zj : p.vj;
      p.vx = __builtin_amdgcn_readfirstlane(nvx); p.vj = __builtin_amdgcn_readfirstlane(nvj);
    }
    __syncthreads();
  }
  run_phase(p, 1); xcd_barrier(xb, p);
  run_phase(p, 2); xcd_barrier(xb, p);
  run_phase(p, 3); xcd_barrier(xb, p);
  run_phase(p, 4); xcd_barrier(xb, p);
  run_phase(p, 5); xcd_barrier(xb, p);
  run_phase(p, 6); xcd_barrier(xb, p);
  run_phase(p, 7);
#if !FUSE_FINAL
  xcd_barrier(xb, p); run_phase(p, 8);
#endif
}
#else
template <int PH>
__global__ void __launch_bounds__(512) fwd_phase(P pin) { P p = pin; p.wv = __builtin_amdgcn_readfirstlane((int)(threadIdx.x >> 6)); p.vx = (int)(blockIdx.x & 7); p.vj = (int)(blockIdx.x >> 3); run_phase(p, PH); }
#endif

extern "C" void kernel_launch(void* const* d_in, const int* in_sizes, int n_in, void* d_out, int out_size,
                              void* d_ws, size_t ws_size, hipStream_t stream) {
  if (ws_size < WS_NEED) { fprintf(stderr, "workspace too small: %zu\n", ws_size); return; }
  P p{};
  p.xp = (const float*)d_in[0]; p.xs = (const float*)d_in[1]; p.g_mix = (const float*)d_in[2];
  p.w_in = (const float*)d_in[3]; p.wgf = (const float*)d_in[4]; p.bgf = (const float*)d_in[5];
  p.wgb = (const float*)d_in[6]; p.bgb = (const float*)d_in[7]; p.g_gla = (const float*)d_in[8];
  p.w_out = (const float*)d_in[9]; p.g_ffn = (const float*)d_in[10]; p.w_fg = (const float*)d_in[11];
  p.w_fu = (const float*)d_in[12]; p.w_fd = (const float*)d_in[13]; p.g_final = (const float*)d_in[14];
  p.out = (float*)d_out; p.ws = (char*)d_ws;
#if MEGA
  static int grid_blocks = 0;
  if (!grid_blocks) {
    hipFuncSetAttribute((const void*)fwd_mega, hipFuncAttributeMaxDynamicSharedMemorySize, SHM_BYTES);
    int dev = 0, cus = 0, per_cu = 0;
    hipGetDevice(&dev);
    hipDeviceGetAttribute(&cus, hipDeviceAttributeMultiprocessorCount, dev);
    hipOccupancyMaxActiveBlocksPerMultiprocessor(&per_cu, fwd_mega, 512, SHM_BYTES);
    if (per_cu < 1) per_cu = 1;
    grid_blocks = cus * per_cu;
    if (grid_blocks > 256) grid_blocks = 256;
  }
  if (grid_blocks != 256) { fprintf(stderr, "need 256 resident blocks, have %d\n", grid_blocks); return; }
  void* args[] = {&p};
  hipError_t e = hipLaunchCooperativeKernel((const void*)fwd_mega, dim3(grid_blocks), dim3(512), args, SHM_BYTES, stream);
  if (e != hipSuccess) fprintf(stderr, "cooperative launch failed: %s (grid %d)\n", hipGetErrorString(e), grid_blocks);
#else
#define LAUNCH(PH) do { hipFuncSetAttribute((const void*)fwd_phase<PH>, hipFuncAttributeMaxDynamicSharedMemorySize, SHM_BYTES); \
    fwd_phase<PH><<<256, 512, SHM_BYTES, stream>>>(p); } while (0)
  LAUNCH(0); LAUNCH(1); LAUNCH(2); LAUNCH(3); LAUNCH(4); LAUNCH(5); LAUNCH(6); LAUNCH(7); LAUNCH(8);
#endif
}
```

```cpp
#include <hip/hip_runtime.h>
#include <hip/hip_cooperative_groups.h>
#include <cstdio>
#include <cstdint>
namespace cg = cooperative_groups;

#ifndef MEGA
#define MEGA 1
#endif
#ifndef FUSE_FINAL
#define FUSE_FINAL 1
#endif

typedef unsigned short u16;
using bf16x8 = __attribute__((ext_vector_type(8))) short;
using f32x4  = __attribute__((ext_vector_type(4))) float;

constexpr int NTOK = 65536;
constexpr int NT_P = 32768;
constexpr size_t MiB = (size_t)1 << 20;
constexpr int SHM_BYTES = 131072;

constexpr size_t OFF_XB   = 0;
constexpr size_t OFF_OMIX = 0;
constexpr size_t OFF_VDT  = 128 * MiB;
constexpr size_t OFF_VAT  = 192 * MiB;
constexpr size_t OFF_RA   = 256 * MiB;
constexpr size_t OFF_QA   = 320 * MiB;
constexpr size_t OFF_KA   = 352 * MiB;
constexpr size_t OFF_LAF  = 384 * MiB;
constexpr size_t OFF_LAB  = 416 * MiB;
constexpr size_t OFF_WIN  = 448 * MiB;
constexpr size_t OFF_X1B  = 352 * MiB;
constexpr size_t OFF_ACT  = 0;
constexpr size_t OFF_WOUT = 480 * MiB;
constexpr size_t OFF_WGU  = 482 * MiB;
constexpr size_t OFF_WDN  = 493 * MiB;
constexpr size_t OFF_ROPE = 499 * MiB;
constexpr size_t OFF_RS1  = 499 * MiB + 512 * 1024;
constexpr size_t OFF_DEC  = 500 * MiB;
constexpr size_t OFF_SSQ1 = 502 * MiB;
constexpr size_t OFF_SSQ2 = 506 * MiB;
constexpr size_t OFF_CNT  = 510 * MiB;
constexpr size_t OFF_BAR  = 510 * MiB + 4096;
constexpr size_t OFF_WGT  = 510 * MiB + 4096 + 16384;
constexpr size_t WS_NEED  = 510 * MiB + 4096 + 16384 + 16384;
constexpr size_t OUT_KV = 0, OUT_QD = 128 * MiB, OUT_KD = 192 * MiB;

struct P {
  const float *xp, *xs, *g_mix, *w_in, *wgf, *bgf, *wgb, *bgb, *g_gla, *w_out, *g_ffn, *w_fg, *w_fu, *w_fd, *g_final;
  float* out;
  char* ws;
  int wv;
  int vx, vj;
  int pad_;
};

typedef __bf16 bf16v2 __attribute__((ext_vector_type(2)));
typedef float f32v2 __attribute__((ext_vector_type(2)));
__device__ __forceinline__ u16 f2bf(float f) { __bf16 h = (__bf16)f; return __builtin_bit_cast(u16, h); }
__device__ __forceinline__ float bf2f(u16 h) { return __uint_as_float(((unsigned)h) << 16); }
__device__ __forceinline__ unsigned pack2(float a, float b) {
  f32v2 f = {a, b}; bf16v2 h = __builtin_convertvector(f, bf16v2); return __builtin_bit_cast(unsigned, h);
}
__device__ __forceinline__ float dpp_swap1(float v) {
  return __uint_as_float((unsigned)__builtin_amdgcn_update_dpp(0, (int)__float_as_uint(v), 0xB1, 0xF, 0xF, true));
}
__device__ __forceinline__ void store_rm4(u16* dst, size_t ld, int row0, int c, float v0, float v1, float v2, float v3, bool odd) {
  {
    float s = odd ? v0 : v1, r = dpp_swap1(s);
    float lo = odd ? r : v0, hi = odd ? v1 : r;
    *(unsigned*)(dst + (size_t)(row0 + (odd ? 1 : 0)) * ld + (c - (odd ? 1 : 0))) = pack2(lo, hi);
  }
  {
    float s = odd ? v2 : v3, r = dpp_swap1(s);
    float lo = odd ? r : v2, hi = odd ? v3 : r;
    *(unsigned*)(dst + (size_t)(row0 + 2 + (odd ? 1 : 0)) * ld + (c - (odd ? 1 : 0))) = pack2(lo, hi);
  }
}
template <int CTRL> __device__ __forceinline__ float dpp_f(float v) {
  return __uint_as_float((unsigned)__builtin_amdgcn_update_dpp(0, (int)__float_as_uint(v), CTRL, 0xF, 0xF, true));
}
__device__ __forceinline__ float row16_sum(float v) {
  v += dpp_f<0x128>(v); v += dpp_f<0x124>(v); v += dpp_f<0x122>(v); v += dpp_f<0x121>(v);
  return v;
}
__device__ __forceinline__ void load_rm4_f32(const float* base, size_t ld, int c, bool odd, float (&x)[4]) {
#pragma unroll
  for (int pr = 0; pr < 2; ++pr) {
    float2 t = *(const float2*)(base + (size_t)(2 * pr + (odd ? 1 : 0)) * ld + (c - (odd ? 1 : 0)));
    float r = dpp_swap1(odd ? t.x : t.y);
    x[2 * pr] = odd ? r : t.x; x[2 * pr + 1] = odd ? t.y : r;
  }
}
__device__ __forceinline__ void load_rm4_bf16(const u16* base, size_t ld, int c, bool odd, float (&x)[4]) {
#pragma unroll
  for (int pr = 0; pr < 2; ++pr) {
    unsigned w = *(const unsigned*)(base + (size_t)(2 * pr + (odd ? 1 : 0)) * ld + (c - (odd ? 1 : 0)));
    float lo = __uint_as_float(w << 16), hi = __uint_as_float(w & 0xffff0000u);
    float r = dpp_swap1(odd ? lo : hi);
    x[2 * pr] = odd ? r : lo; x[2 * pr + 1] = odd ? hi : r;
  }
}
__device__ __forceinline__ void store_rm4_f32(float* base, size_t ld, int c, bool odd, float v0, float v1, float v2, float v3) {
  {
    float r = dpp_swap1(odd ? v0 : v1);
    float2 w; w.x = odd ? r : v0; w.y = odd ? v1 : r;
    *(float2*)(base + (size_t)(odd ? 1 : 0) * ld + (c - (odd ? 1 : 0))) = w;
  }
  {
    float r = dpp_swap1(odd ? v2 : v3);
    float2 w; w.x = odd ? r : v2; w.y = odd ? v3 : r;
    *(float2*)(base + (size_t)(2 + (odd ? 1 : 0)) * ld + (c - (odd ? 1 : 0))) = w;
  }
}
__device__ __forceinline__ float fast_silu(float z) { return z * __builtin_amdgcn_rcpf(1.f + __expf(-z)); }
__device__ __forceinline__ int opaque_tid(const P& p) {
  int lane;
  asm volatile("v_mbcnt_lo_u32_b32 %0, -1, 0\n\tv_mbcnt_hi_u32_b32 %0, -1, %0" : "=v"(lane));
  return p.wv * 64 + lane;
}
__device__ __forceinline__ const float* xrow(const P& p, int tok) {
  return tok < NT_P ? p.xp + (size_t)tok * 1024 : p.xs + (size_t)(tok - NT_P) * 1024;
}

constexpr int BK = 64, HALF = 128, HT = HALF * BK;

__device__ __forceinline__ int lds_byte(int r, int c) {
  int st = (r >> 4) * 2 + (c >> 5), rr = r & 15, cc = c & 31, ob = rr * 64 + cc * 2;
  return st * 1024 + (ob ^ (((ob >> 9) & 1) << 5));
}
__device__ __forceinline__ void stage_rc(int b, int& R, int& C) {
  int st = b / 1024, sb = b % 1024, swz = sb ^ (((sb >> 9) & 1) << 5);
  R = (st >> 1) * 16 + swz / 64; C = (st & 1) * 32 + (swz % 64) / 2;
}

template <class Epi>
__device__ __forceinline__ void gemm_tile(const u16* __restrict__ A, const u16* __restrict__ Bt, int K,
                                          int brow, int bcol, bool first, bool has_next, int nbrow, int nbcol, Epi epi) {
  extern __shared__ __attribute__((aligned(16))) u16 shm[];
#define SA(b, h) (shm + ((b) * 2 + (h)) * HT)
#define SB(b, h) (shm + (4 + (b) * 2 + (h)) * HT)
#define STAGE(Pp, BASE, br, kt) do { const char* _gb = (const char*)((BASE) + (long)(br) * K + (long)(kt) * BK); \
    __builtin_amdgcn_global_load_lds((const unsigned*)(_gb + voff0), \
        (__attribute__((address_space(3))) unsigned*)((char*)(Pp) + tidx * 16), 16, 0, 0); \
    __builtin_amdgcn_global_load_lds((const unsigned*)(_gb + voff1), \
        (__attribute__((address_space(3))) unsigned*)((char*)(Pp) + tidx * 16 + 8192), 16, 0, 0); } while (0)
#define LDA(dst, b, h) for (int m = 0; m < 4; ++m) for (int k = 0; k < 2; ++k) \
    dst[m][k] = *reinterpret_cast<const bf16x8*>((char*)SA(b, h) + lds_byte(wr * 64 + m * 16 + fr, k * 32 + fq * 8))
#define LDB(dst, b, h) for (int n = 0; n < 2; ++n) for (int k = 0; k < 2; ++k) \
    dst[n][k] = *reinterpret_cast<const bf16x8*>((char*)SB(b, h) + lds_byte(wc * 32 + n * 16 + fr, k * 32 + fq * 8))
#define MMA(ai, bj, At, Bq) do { __builtin_amdgcn_s_setprio(1); \
    for (int m = 0; m < 4; ++m) for (int n = 0; n < 2; ++n) for (int k = 0; k < 2; ++k) \
      acc[ai][bj][m][n] = __builtin_amdgcn_mfma_f32_16x16x32_bf16(At[m][k], Bq[n][k], acc[ai][bj][m][n], 0, 0, 0); \
    __builtin_amdgcn_s_setprio(0); } while (0)
#define WAIT_V(n) asm volatile("s_waitcnt vmcnt(" #n ")" ::: "memory")
#define WAIT_L(n) asm volatile("s_waitcnt lgkmcnt(" #n ")" ::: "memory")
#define BAR __builtin_amdgcn_s_barrier()
#define SCHED __builtin_amdgcn_sched_barrier(0)

  const int tidx = opaque_tid(epi.p);
  int wid = tidx >> 6, lane = tidx & 63, wr = wid >> 2, wc = wid & 3, fr = lane & 15, fq = lane >> 4;
  unsigned voff0, voff1;
  { int _r, _c; stage_rc(tidx * 16, _r, _c); voff0 = (unsigned)(_r * K + _c) * 2u;
    stage_rc(tidx * 16 + 8192, _r, _c); voff1 = (unsigned)(_r * K + _c) * 2u; }
  f32x4 acc[2][2][4][2] = {};
  bf16x8 At[4][2], B0[2][2], B1[2][2];
  int nt = K / BK;
  if (first) {
    STAGE(SB(0, 0), Bt, bcol, 0); STAGE(SA(0, 0), A, brow, 0);
    STAGE(SB(0, 1), Bt, bcol + HALF, 0); STAGE(SA(0, 1), A, brow + HALF, 0);
    if (wr == 1) BAR;
    WAIT_V(4); BAR;
    STAGE(SB(1, 0), Bt, bcol, 1); STAGE(SA(1, 0), A, brow, 1); STAGE(SB(1, 1), Bt, bcol + HALF, 1);
    WAIT_V(6); BAR;
  } else {
    if (wr == 1) BAR;
    WAIT_V(16); BAR;
  }
  for (int t = 0; t < nt - 2; t += 2) {
    LDB(B0, 0, 0); SCHED; LDA(At, 0, 0); STAGE(SA(1, 1), A, brow + HALF, t + 1);
    WAIT_L(8); BAR; WAIT_L(0); MMA(0, 0, At, B0); BAR; SCHED;
    LDB(B1, 0, 1); STAGE(SB(0, 0), Bt, bcol, t + 2);
    BAR; WAIT_L(0); MMA(0, 1, At, B1); BAR;
    LDA(At, 0, 1); STAGE(SA(0, 0), A, brow, t + 2);
    BAR; WAIT_L(0); MMA(1, 0, At, B0); BAR; SCHED;
    STAGE(SB(0, 1), Bt, bcol + HALF, t + 2);
    WAIT_V(6); BAR; MMA(1, 1, At, B1); BAR;
    LDB(B0, 1, 0); SCHED; LDA(At, 1, 0); STAGE(SA(0, 1), A, brow + HALF, t + 2);
    WAIT_L(8); BAR; WAIT_L(0); MMA(0, 0, At, B0); BAR; SCHED;
    LDB(B1, 1, 1); STAGE(SB(1, 0), Bt, bcol, t + 3);
    BAR; WAIT_L(0); MMA(0, 1, At, B1); BAR;
    LDA(At, 1, 1); STAGE(SA(1, 0), A, brow, t + 3);
    BAR; WAIT_L(0); MMA(1, 0, At, B0); BAR; SCHED;
    STAGE(SB(1, 1), Bt, bcol + HALF, t + 3);
    WAIT_V(6); BAR; MMA(1, 1, At, B1); BAR;
  }
  { LDB(B0, 0, 0); LDA(At, 0, 0); STAGE(SA(1, 1), A, brow + HALF, nt - 1);
    BAR; WAIT_L(0); MMA(0, 0, At, B0); BAR;
    LDB(B1, 0, 1); BAR; WAIT_L(0); MMA(0, 1, At, B1); BAR;
    LDA(At, 0, 1); WAIT_V(4); BAR; WAIT_L(0); MMA(1, 0, At, B0); MMA(1, 1, At, B1); BAR; }
  { LDB(B0, 1, 0); LDA(At, 1, 0); WAIT_V(2); BAR; WAIT_L(0); MMA(0, 0, At, B0); BAR;
    LDB(B1, 1, 1); WAIT_V(0); BAR; WAIT_L(0); MMA(0, 1, At, B1); BAR;
    LDA(At, 1, 1); BAR; WAIT_L(0); MMA(1, 0, At, B0); MMA(1, 1, At, B1); BAR; }
  if (wr == 0) BAR;
  if (has_next) {
    STAGE(SB(0, 0), Bt, nbcol, 0); STAGE(SA(0, 0), A, nbrow, 0);
    STAGE(SB(0, 1), Bt, nbcol + HALF, 0); STAGE(SA(0, 1), A, nbrow + HALF, 0);
    STAGE(SB(1, 0), Bt, nbcol, 1); STAGE(SA(1, 0), A, nbrow, 1); STAGE(SB(1, 1), Bt, nbcol + HALF, 1);
  }
  { int t2 = opaque_tid(epi.p);
    int w2 = t2 >> 6, l2 = t2 & 63;
    epi(acc, brow, bcol, w2 >> 2, w2 & 3, l2 & 15, l2 >> 4); }
  WAIT_L(0); BAR;
#undef SA
#undef SB
}

template <class Epi>
__device__ __forceinline__ void gemm_phase(const u16* A, const u16* Bt, int K, int nN, Epi epi) {
  {
    int x = epi.p.vx, j = epi.p.vj;
    int li = j;
    int mg = li / (nN * 8), rem = li % (nN * 8);
    int brow = (x * 32 + mg * 8 + (rem & 7)) * 256, bcol = (rem >> 3) * 256;
    for (int rd = 0; rd < nN; ++rd) {
      int nbrow = 0, nbcol = 0;
      bool has_next = rd + 1 < nN;
      if (has_next) {
        int l2 = (rd + 1) * 32 + j;
        int mg2 = l2 / (nN * 8), rem2 = l2 % (nN * 8);
        nbrow = (x * 32 + mg2 * 8 + (rem2 & 7)) * 256; nbcol = (rem2 >> 3) * 256;
      }
      gemm_tile(A, Bt, K, brow, bcol, rd == 0, has_next, nbrow, nbcol, epi);
      brow = nbrow; bcol = nbcol;
    }
  }
}

template <class Src>
__device__ __forceinline__ void wt_tile(u16* dst, int ldk, int n0, int k0, Src src, float* tile, int t) {
  int nl = t & 63, kb = t >> 6;
#pragma unroll
  for (int i = 0; i < 8; ++i) {
    int kl = kb + 8 * i;
    tile[kl * 65 + nl] = src(k0 + kl, n0 + nl);
  }
  __syncthreads();
#pragma unroll
  for (int i = 0; i < 8; ++i) {
    int n = kb + 8 * i;
    dst[(size_t)(n0 + n) * ldk + k0 + nl] = f2bf(tile[nl * 65 + n]);
  }
  __syncthreads();
}

__device__ void phase_prep(const P& p) {
  extern __shared__ __attribute__((aligned(16))) u16 shm[];
  float* tile = (float*)shm;
  int tid = opaque_tid(p), lane = tid & 63, wid = tid >> 6;
  u16* xb = (u16*)(p.ws + OFF_XB);
  float* rs1 = (float*)(p.ws + OFF_RS1);
  for (int row = (blockIdx.x * 8 + wid) * 2; row < NTOK; row += gridDim.x * 16) {
    const float4* src0 = (const float4*)xrow(p, row);
    const float4* src1 = (const float4*)xrow(p, row + 1);
    float4 v0[4], v1[4];
#pragma unroll
    for (int i = 0; i < 4; ++i) { v0[i] = src0[lane + i * 64]; v1[i] = src1[lane + i * 64]; }
    float ss0 = 0.f, ss1 = 0.f;
    uint2* dst0 = (uint2*)(xb + (size_t)row * 1024);
    uint2* dst1 = (uint2*)(xb + (size_t)(row + 1) * 1024);
#pragma unroll
    for (int i = 0; i < 4; ++i) {
      ss0 += v0[i].x * v0[i].x + v0[i].y * v0[i].y + v0[i].z * v0[i].z + v0[i].w * v0[i].w;
      ss1 += v1[i].x * v1[i].x + v1[i].y * v1[i].y + v1[i].z * v1[i].z + v1[i].w * v1[i].w;
      uint2 o; o.x = pack2(v0[i].x, v0[i].y); o.y = pack2(v0[i].z, v0[i].w); dst0[lane + i * 64] = o;
      o.x = pack2(v1[i].x, v1[i].y); o.y = pack2(v1[i].z, v1[i].w); dst1[lane + i * 64] = o;
    }
#pragma unroll
    for (int s2 = 32; s2 >= 1; s2 >>= 1) { ss0 += __shfl_xor(ss0, s2); ss1 += __shfl_xor(ss1, s2); }
    if (lane == 0) { rs1[row] = rsqrtf(ss0 * (1.f / 1024.f) + 1e-6f); rs1[row + 1] = rsqrtf(ss1 * (1.f / 1024.f) + 1e-6f); }
  }
  u16* win = (u16*)(p.ws + OFF_WIN);
  u16* wout = (u16*)(p.ws + OFF_WOUT);
  u16* wgu = (u16*)(p.ws + OFF_WGU);
  u16* wdn = (u16*)(p.ws + OFF_WDN);
  const int J0 = 768, J1 = J0 + 64, J2 = J1 + 256, J3 = J2 + 1408, J4 = J3 + 704;
  for (int it = blockIdx.x; it < J4; it += gridDim.x) {
    if (it < J0) {
      int n0 = (it >> 4) * 64, k0 = (it & 15) * 64;
      wt_tile(win, 1024, n0, k0, [&](int k, int n) { return p.w_in[(size_t)k * 3104 + n] * p.g_mix[k]; }, tile, tid);
    } else if (it < J1) {
      int q = it - J0; int n0 = (q >> 4) * 64, k0 = (q & 15) * 64;
      wt_tile(win + (size_t)3072 * 1024, 1024, n0, k0, [&](int k, int n) {
        return n < 32 ? p.w_in[(size_t)k * 3104 + 3072 + n] * p.g_mix[k] : 0.f; }, tile, tid);
    } else if (it < J2) {
      int q = it - J1; int n0 = (q >> 4) * 64, k0 = (q & 15) * 64;
      wt_tile(wout, 1024, n0, k0, [&](int k, int n) { return p.w_out[(size_t)k * 1024 + n]; }, tile, tid);
    } else if (it < J3) {
      int q = it - J2; int n0 = (q >> 4) * 64, k0 = (q & 15) * 64;
      wt_tile(wgu, 1024, n0, k0, [&](int k, int n) {
        int t = n >> 8, w = n & 255; int ff = t * 128 + (w & 127);
        const float* W = (w < 128) ? p.w_fg : p.w_fu;
        return W[(size_t)k * 2816 + ff] * p.g_ffn[k]; }, tile, tid);
    } else {
      int q = it - J3; int n0 = (q / 44) * 64, k0 = (q % 44) * 64;
      wt_tile(wdn, 2816, n0, k0, [&](int k, int n) { return p.w_fd[(size_t)k * 1024 + n]; }, tile, tid);
    }
  }
  if (blockIdx.x == 0 && tid < 256) ((unsigned*)(p.ws + OFF_CNT))[tid] = 0u;
#if FUSE_FINAL
  { uint4* g4 = (uint4*)(p.ws + OFF_SSQ2);
    for (int i = blockIdx.x * 512 + tid; i < (2 << 20) / 16; i += gridDim.x * 512) g4[i] = make_uint4(0u, 0u, 0u, 0u); }
#endif
  { u16* wgt = (u16*)(p.ws + OFF_WGT);
    for (int idx = blockIdx.x * 512 + tid; idx < 8192; idx += gridDim.x * 512) {
      int dir = idx >> 12, col = (idx >> 4) & 255, r = idx & 15;
      wgt[idx] = f2bf((dir ? p.wgb : p.wgf)[r * 256 + col]);
    } }
  float* rope = (float*)(p.ws + OFF_ROPE);
  for (int idx = blockIdx.x * 512 + tid; idx < 8192 * 8; idx += gridDim.x * 512) {
    int pos = idx >> 3, i = idx & 7;
    float inv = exp2f(-((float)i * 0.125f) * log2f(500000.f));
    float ang = (float)pos * inv;
    double a = (double)ang;
    double rr = a - 6.283185307179586 * rint(a * 0.15915494309189535);
    float rf = (float)rr;
    rope[idx * 2] = cosf(rf);
    rope[idx * 2 + 1] = sinf(rf);
  }
}

struct EpiIn {
  P p;
  __device__ __forceinline__ void operator()(f32x4 (&acc)[2][2][4][2], int brow, int bcol, int wr, int wc, int fr, int fq) const {
    const float* rs1 = (const float*)(p.ws + OFF_RS1);
    int nt = bcol >> 8;
    char* outb = (char*)p.out;
    float4 rsq[2][4];
#pragma unroll
    for (int ai = 0; ai < 2; ++ai)
#pragma unroll
      for (int m = 0; m < 4; ++m) rsq[ai][m] = *(const float4*)(rs1 + brow + ai * 128 + wr * 64 + m * 16 + fq * 4);
    __builtin_amdgcn_sched_barrier(0);
    if (nt < 4) {
      u16* dst = (u16*)(outb + (nt < 2 ? OUT_QD : OUT_KD));
      float sc = nt < 2 ? 0.125f * 1.4426950408889634f : 1.f;
      int cbase = (nt & 1) * 256;
      const float2* rope = (const float2*)(p.ws + OFF_ROPE);
      int posmask = brow < NT_P ? 4095 : 8191;
      bool rot = (wc & 1) == 0;
      float2 csc[4], csn[4];
#pragma unroll
      for (int j = 0; j < 4; ++j) csc[j] = rope[((brow + wr * 64 + fq * 4 + j) & posmask) * 8 + (fr & 7)];
#pragma unroll
      for (int ch = 0; ch < 8; ++ch) {
        const int ai = ch >> 2, m = ch & 3;
        int row0 = brow + ai * 128 + wr * 64 + m * 16 + fq * 4;
        if (ch + 1 < 8) {
          int rown = brow + ((ch + 1) >> 2) * 128 + wr * 64 + ((ch + 1) & 3) * 16 + fq * 4;
#pragma unroll
          for (int j = 0; j < 4; ++j) csn[j] = rope[((rown + j) & posmask) * 8 + (fr & 7)];
        }
        __builtin_amdgcn_sched_barrier(0);
        float4 r4 = rsq[ai][m];
        float rr[4] = {r4.x * sc, r4.y * sc, r4.z * sc, r4.w * sc};
        float va[2][4], vb[2][4];
#pragma unroll
        for (int j = 0; j < 4; ++j) {
          float2 cs = csc[j];
#pragma unroll
          for (int bj = 0; bj < 2; ++bj) {
            float v = acc[ai][bj][m][0][j];
            float pr = dpp_f<0x128>(v);
            float sg = (fr < 8) ? -pr : pr;
            float vr = v * cs.x + sg * cs.y;
            v = rot ? vr : v;
            va[bj][j] = v * rr[j];
            vb[bj][j] = acc[ai][bj][m][1][j] * rr[j];
          }
        }
#pragma unroll
        for (int bj = 0; bj < 2; ++bj) {
          int c = cbase + bj * 128 + wc * 32 + fr;
          store_rm4(dst, 512, row0, c, va[bj][0], va[bj][1], va[bj][2], va[bj][3], fr & 1);
          store_rm4(dst, 512, row0, c + 16, vb[bj][0], vb[bj][1], vb[bj][2], vb[bj][3], fr & 1);
        }
        __builtin_amdgcn_sched_barrier(0);
#pragma unroll
        for (int j = 0; j < 4; ++j) csc[j] = csn[j];
      }
    } else if (nt < 6) {
      u16* dst = (u16*)(p.ws + OFF_VDT);
      int L, seq0;
      if (brow < NT_P) { L = 4096; seq0 = brow & ~4095; } else { L = 8192; seq0 = NT_P + ((brow - NT_P) & ~8191); }
      int L16 = L >> 4;
      int cbase = (nt & 1) * 256;
#pragma unroll
      for (int ai = 0; ai < 2; ++ai) {
        int pos0 = brow - seq0 + ai * 128 + wr * 64;
        int idx16 = pos0 >> 4;
        float4 r4[4];
#pragma unroll
        for (int m = 0; m < 4; ++m) r4[m] = rsq[ai][m];
#pragma unroll
        for (int bj = 0; bj < 2; ++bj) {
#pragma unroll
          for (int n = 0; n < 2; ++n) {
            int c = cbase + bj * 128 + wc * 32 + n * 16 + fr;
            int h = c >> 6, d = c & 63;
            u16* dcol = dst + (size_t)seq0 * 512 + ((size_t)(h * 16 + fq * 4) * (L16 >> 2) + (idx16 >> 2)) * 256 + d * 4;
#pragma unroll
            for (int j = 0; j < 4; ++j) {
              uint2 o;
              float a0 = acc[ai][bj][0][n][j] * (j == 0 ? r4[0].x : j == 1 ? r4[0].y : j == 2 ? r4[0].z : r4[0].w);
              float a1 = acc[ai][bj][1][n][j] * (j == 0 ? r4[1].x : j == 1 ? r4[1].y : j == 2 ? r4[1].z : r4[1].w);
              float a2 = acc[ai][bj][2][n][j] * (j == 0 ? r4[2].x : j == 1 ? r4[2].y : j == 2 ? r4[2].z : r4[2].w);
              float a3 = acc[ai][bj][3][n][j] * (j == 0 ? r4[3].x : j == 1 ? r4[3].y : j == 2 ? r4[3].z : r4[3].w);
              o.x = pack2(a0, a1); o.y = pack2(a2, a3);
              *(uint2*)(dcol + (size_t)j * 64 * L16) = o;
            }
          }
          __builtin_amdgcn_sched_barrier(0);
        }
      }
    } else if (nt < 8) {
      u16* dst = (u16*)(p.ws + (nt == 6 ? OFF_QA : OFF_KA));
      float sc = nt == 6 ? 0.125f : 1.f;
#pragma unroll
      for (int ai = 0; ai < 2; ++ai)
#pragma unroll
        for (int m = 0; m < 4; ++m) {
          int row0 = brow + ai * 128 + wr * 64 + m * 16 + fq * 4;
          float4 r4 = rsq[ai][m];
          float rr[4] = {r4.x * sc, r4.y * sc, r4.z * sc, r4.w * sc};
#pragma unroll
          for (int bj = 0; bj < 2; ++bj)
#pragma unroll
            for (int n = 0; n < 2; ++n) {
              int c = bj * 128 + wc * 32 + n * 16 + fr;
              store_rm4(dst, 256, row0, c, acc[ai][bj][m][n][0] * rr[0], acc[ai][bj][m][n][1] * rr[1],
                        acc[ai][bj][m][n][2] * rr[2], acc[ai][bj][m][n][3] * rr[3], fr & 1);
            }
          __builtin_amdgcn_sched_barrier(0);
        }
    } else if (nt < 10) {
      u16* dst = (u16*)(p.ws + OFF_VAT);
      int cbase = (nt & 1) * 256;
#pragma unroll
      for (int ai = 0; ai < 2; ++ai) {
        int chunk = (brow + ai * 128 + wr * 64) >> 6;
#pragma unroll
        for (int m = 0; m < 4; ++m) {
          float4 r4 = rsq[ai][m];
#pragma unroll
          for (int bj = 0; bj < 2; ++bj)
#pragma unroll
            for (int n = 0; n < 2; ++n) {
              int c = cbase + bj * 128 + wc * 32 + n * 16 + fr;
              int h = c >> 7, dv = c & 127;
              uint2 o;
              o.x = pack2(acc[ai][bj][m][n][0] * r4.x, acc[ai][bj][m][n][1] * r4.y);
              o.y = pack2(acc[ai][bj][m][n][2] * r4.z, acc[ai][bj][m][n][3] * r4.w);
              *(uint2*)(dst + ((size_t)(chunk * 4 + h) * 128 + dv) * 64 + m * 16 + fq * 4) = o;
            }
          __builtin_amdgcn_sched_barrier(0);
        }
      }
    } else if (nt < 12) {
      u16* dst = (u16*)(p.ws + OFF_RA);
      int cbase = (nt & 1) * 256;
#pragma unroll
      for (int ai = 0; ai < 2; ++ai) {
        int chunk = (brow + ai * 128 + wr * 64) >> 6;
#pragma unroll
        for (int m = 0; m < 4; ++m) {
          float4 r4 = rsq[ai][m];
#pragma unroll
          for (int bj = 0; bj < 2; ++bj)
#pragma unroll
            for (int n = 0; n < 2; ++n) {
              int c = cbase + bj * 128 + wc * 32 + n * 16 + fr;
              int h = c >> 7, dv = c & 127;
              uint2 o;
              o.x = pack2(fast_silu(acc[ai][bj][m][n][0] * r4.x), fast_silu(acc[ai][bj][m][n][1] * r4.y));
              o.y = pack2(fast_silu(acc[ai][bj][m][n][2] * r4.z), fast_silu(acc[ai][bj][m][n][3] * r4.w));
              *(uint2*)(dst + ((size_t)(chunk * 4 + h) * 128 + dv) * 64 + m * 16 + fq * 4) = o;
            }
          __builtin_amdgcn_sched_barrier(0);
        }
      }
    } else {
      extern __shared__ __attribute__((aligned(16))) u16 shm[];
      u16* glr = (u16*)((char*)shm + 3 * HT * 2);
      if (wc == 0) {
#pragma unroll
        for (int ai = 0; ai < 2; ++ai)
#pragma unroll
          for (int m = 0; m < 4; ++m) {
            int rl0 = ai * 128 + wr * 64 + m * 16 + fq * 4;
            float4 r4 = rsq[ai][m];
            float rr[4] = {r4.x, r4.y, r4.z, r4.w};
#pragma unroll
            for (int n = 0; n < 2; ++n)
#pragma unroll
              for (int j = 0; j < 4; ++j) glr[(rl0 + j) * 32 + n * 16 + fr] = f2bf(acc[ai][0][m][n][j] * rr[j]);
          }
      }
      __syncthreads();
      typedef short s16x4 __attribute__((ext_vector_type(4)));
      const u16* wgt = (const u16*)(p.ws + OFF_WGT);
#pragma unroll
      for (int dir = 0; dir < 2; ++dir) {
        s16x4 bfr[2][2];
#pragma unroll
        for (int bj = 0; bj < 2; ++bj)
#pragma unroll
          for (int n = 0; n < 2; ++n)
            bfr[bj][n] = *(const s16x4*)(wgt + ((size_t)(dir * 256 + bj * 128 + wc * 32 + n * 16 + fr)) * 16 + fq * 4);
        u16* dst = (u16*)(p.ws + (dir == 0 ? OFF_LAF : OFF_LAB));
        const float* bias = dir == 0 ? p.bgf : p.bgb;
#pragma unroll
        for (int ai = 0; ai < 2; ++ai)
#pragma unroll
          for (int m = 0; m < 4; ++m) {
            int rl = ai * 128 + wr * 64 + m * 16;
            s16x4 af = *(const s16x4*)(glr + (rl + fr) * 32 + dir * 16 + fq * 4);
            int row0 = brow + rl + fq * 4;
#pragma unroll
            for (int bj = 0; bj < 2; ++bj)
#pragma unroll
              for (int n = 0; n < 2; ++n) {
                f32x4 z4 = {0.f, 0.f, 0.f, 0.f};
                z4 = __builtin_amdgcn_mfma_f32_16x16x16bf16_1k(af, bfr[bj][n], z4, 0, 0, 0);
                int c = bj * 128 + wc * 32 + n * 16 + fr;
                float bb = bias[c];
                float ls[4];
#pragma unroll
                for (int j = 0; j < 4; ++j) {
                  float z = z4[j] + bb;
                  ls[j] = (fminf(z, 0.f) - __logf(1.f + __expf(-fabsf(z)))) * (1.f / 16.f);
                }
                store_rm4(dst, 256, row0, c, ls[0], ls[1], ls[2], ls[3], fr & 1);
              }
            __builtin_amdgcn_sched_barrier(0);
          }
      }
    }
  }
};

typedef bf16x8 __attribute__((aligned(8))) bf16x8_a8;
struct KVB { bf16x8 k0, k1, k2, k3; bf16x8 v0, v1, v2, v3; };
constexpr int ATT_NKS = 23;

__device__ __forceinline__ void attn_desc(int ks, int g, int r, int i0, int& c, int& s) {
  if (ks < 12) { c = 4 * (ks & 3) + g; s = i0 - 4 + 8 * (ks >> 2); }
  else if (ks < 18) { c = (r & 3) + 4 * g; s = i0 - 16 + 8 * (ks - 12); }
  else { c = r; s = i0 - 64 + 8 * ((ks - 18) * 4 + g); }
}

__device__ __forceinline__ KVB attn_load(int ks, const u16* __restrict__ kbase, const u16* __restrict__ vbase, int L16,
                                         int r, int i0, int lane) {
  KVB b;
  const int quad = lane >> 4, l15 = lane & 15, gk = l15 >> 2, ek = l15 & 3;
  int cK, sK; attn_desc(ks, gk, r, i0, cK, sK);
  int ia = sK + ek, ib = ia + 4;
  ia = min(max(ia, 0), L16 - 1); ib = min(max(ib, 0), L16 - 1);
  const u16* ka = kbase + (size_t)(cK + 16 * ia) * 512;
  const u16* kb = kbase + (size_t)(cK + 16 * ib) * 512;
  b.k0 = *(const bf16x8*)ka; b.k1 = *(const bf16x8*)(ka + 8);
  b.k2 = *(const bf16x8*)kb; b.k3 = *(const bf16x8*)(kb + 8);
  int cV, sV; attn_desc(ks, quad, r, i0, cV, sV);
  const u16* vp = vbase + ((ptrdiff_t)cV * (L16 >> 2) + (sV >> 2)) * 256 + l15 * 4;
  {
    union { struct { uint2 a, b; } p; bf16x8 v; } c0, c1, c2, c3;
    c0.p.a = *(const uint2*)(vp);        c0.p.b = *(const uint2*)(vp + 256);
    c1.p.a = *(const uint2*)(vp + 64);   c1.p.b = *(const uint2*)(vp + 64 + 256);
    c2.p.a = *(const uint2*)(vp + 128);  c2.p.b = *(const uint2*)(vp + 128 + 256);
    c3.p.a = *(const uint2*)(vp + 192);  c3.p.b = *(const uint2*)(vp + 192 + 256);
    b.v0 = c0.v; b.v1 = c1.v; b.v2 = c2.v; b.v3 = c3.v;
  }
  return b;
}

__device__ __forceinline__ void attn_step(int ks, const KVB& b, int L16, int r, int i0, int iq, int lane,
                                          const bf16x8* qs, f32x4 (&o)[4], float& mrun, float& lrun) {
  asm volatile("" : "+v"(lane), "+v"(iq));
  asm volatile("" : "+s"(r), "+s"(i0));
  const int quad = lane >> 4;
  bf16x8 qB0 = qs[0], qB1 = qs[64];
  int cV, sV; attn_desc(ks, quad, r, i0, cV, sV);
  int D = ks < 12 ? 4 : (ks < 18 ? 16 : 64);
  f32x4 z = {0.f, 0.f, 0.f, 0.f};
  f32x4 sa = __builtin_amdgcn_mfma_f32_16x16x32_bf16(b.k0, qB0, z, 0, 0, 0);
  sa = __builtin_amdgcn_mfma_f32_16x16x32_bf16(b.k1, qB1, sa, 0, 0, 0);
  f32x4 sb = __builtin_amdgcn_mfma_f32_16x16x32_bf16(b.k2, qB0, z, 0, 0, 0);
  sb = __builtin_amdgcn_mfma_f32_16x16x32_bf16(b.k3, qB1, sb, 0, 0, 0);
  int jlo = max(iq - D + (cV < r ? 1 : 0), 0) - sV;
  int jhi = min(iq + D - (cV > r ? 1 : 0), L16 - 1) - sV;
  const float NINF = -__builtin_inff();
  float s8[8];
  float mt = -1e30f;
#pragma unroll
  for (int j = 0; j < 8; ++j) {
    float sv = j < 4 ? sa[j] : sb[j - 4];
    sv = (j >= jlo && j <= jhi) ? sv : NINF;
    s8[j] = sv;
    mt = fmaxf(mt, sv);
  }
  mt = fmaxf(mt, __shfl_xor(mt, 16));
  mt = fmaxf(mt, __shfl_xor(mt, 32));
  float mnew = fmaxf(mrun, mt);
  float alpha = __builtin_amdgcn_exp2f(mrun - mnew);
  mrun = mnew;
  float ps = 0.f;
  float p8[8];
#pragma unroll
  for (int j = 0; j < 8; ++j) { p8[j] = __builtin_amdgcn_exp2f(s8[j] - mnew); ps += p8[j]; }
  lrun = lrun * alpha + ps;
  union { uint4 u; bf16x8 v; } pb;
  pb.u = make_uint4(pack2(p8[0], p8[1]), pack2(p8[2], p8[3]), pack2(p8[4], p8[5]), pack2(p8[6], p8[7]));
#pragma unroll
  for (int dt = 0; dt < 4; ++dt) { o[dt][0] *= alpha; o[dt][1] *= alpha; o[dt][2] *= alpha; o[dt][3] *= alpha; }
  o[0] = __builtin_amdgcn_mfma_f32_16x16x32_bf16(b.v0, pb.v, o[0], 0, 0, 0);
  o[1] = __builtin_amdgcn_mfma_f32_16x16x32_bf16(b.v1, pb.v, o[1], 0, 0, 0);
  o[2] = __builtin_amdgcn_mfma_f32_16x16x32_bf16(b.v2, pb.v, o[2], 0, 0, 0);
  o[3] = __builtin_amdgcn_mfma_f32_16x16x32_bf16(b.v3, pb.v, o[3], 0, 0, 0);
}

template <int NT>
__device__ __forceinline__ KVB attn_load_e(int e, const u16* kbase, const u16* vbase, int L16, int rb, int i0, int lane) {
  int ks, r;
  if (e < 18) { ks = e; r = rb; } else { int f = e - 18; ks = 18 + f / NT; r = rb + (16 / NT) * (f % NT); }
  return attn_load(ks, kbase, vbase, L16, r, i0, lane);
}

template <int NT>
__device__ void attn_unitN(const P& p, int u) {
  constexpr int RS = 16 / NT;
  constexpr int EMAX = 18 + 5 * NT - 1;
  int lane = opaque_tid(p) & 63, q = lane & 15, quad = lane >> 4;
  int rb = u % RS, h = (u / RS) & 7, span = u / (RS * 8);
  int tb = span * 256;
  int seq0, L;
  if (tb < NT_P) { L = 4096; seq0 = tb & ~4095; } else { L = 8192; seq0 = NT_P + ((tb - NT_P) & ~8191); }
  int L16 = L >> 4;
  int i0 = (tb - seq0) >> 4;
  int iq = i0 + q;
  const u16* Qd = (const u16*)((const char*)p.out + OUT_QD);
  const u16* Kd = (const u16*)((const char*)p.out + OUT_KD);
  const u16* VdT = (const u16*)(p.ws + OFF_VDT);
  extern __shared__ __attribute__((aligned(16))) u16 shm[];
  bf16x8* qs = (bf16x8*)((char*)shm + __builtin_amdgcn_readfirstlane(opaque_tid(p) >> 6) * 8192) + lane;
  f32x4 o[NT][4];
  float mrun[NT], lrun[NT];
#pragma unroll
  for (int t = 0; t < NT; ++t) {
    const u16* qp = Qd + (size_t)(seq0 + rb + RS * t + 16 * iq) * 512 + h * 64 + quad * 16;
    qs[t * 128] = *(const bf16x8*)qp; qs[t * 128 + 64] = *(const bf16x8*)(qp + 8);
#pragma unroll
    for (int dt = 0; dt < 4; ++dt) o[t][dt] = f32x4{0.f, 0.f, 0.f, 0.f};
    mrun[t] = -1e30f; lrun[t] = 0.f;
  }
  const u16* kbase = Kd + (size_t)seq0 * 512 + h * 64 + quad * 16;
  const u16* vbase = VdT + (size_t)seq0 * 512 + (size_t)h * 16 * 64 * L16;
  KVB bA = attn_load_e<NT>(0, kbase, vbase, L16, rb, i0, lane);
  KVB bB = attn_load_e<NT>(1, kbase, vbase, L16, rb, i0, lane);
#pragma unroll 1
  for (int ks = 0; ks < 18; ks += 2) {
#pragma unroll
    for (int t = 0; t < NT; ++t)
      attn_step(ks, bA, L16, rb + RS * t, i0, iq, lane, qs + t * 128, o[t], mrun[t], lrun[t]);
    bA = attn_load_e<NT>(ks + 2, kbase, vbase, L16, rb, i0, lane);
#pragma unroll
    for (int t = 0; t < NT; ++t)
      attn_step(ks + 1, bB, L16, rb + RS * t, i0, iq, lane, qs + t * 128, o[t], mrun[t], lrun[t]);
    bB = attn_load_e<NT>(ks + 3, kbase, vbase, L16, rb, i0, lane);
  }
#pragma unroll 1
  for (int kk = 0; kk < 5; ++kk) {
    int e0 = 18 + NT * kk, ks = 18 + kk;
#pragma unroll
    for (int t = 0; t < NT; t += 2) {
      attn_step(ks, bA, L16, rb + RS * t, i0, iq, lane, qs + t * 128, o[t], mrun[t], lrun[t]);
      bA = attn_load_e<NT>(min(e0 + t + 2, EMAX), kbase, vbase, L16, rb, i0, lane);
      attn_step(ks, bB, L16, rb + RS * (t + 1), i0, iq, lane, qs + (t + 1) * 128, o[t + 1], mrun[t + 1], lrun[t + 1]);
      bB = attn_load_e<NT>(min(e0 + t + 3, EMAX), kbase, vbase, L16, rb, i0, lane);
    }
  }
  u16* omix = (u16*)(p.ws + OFF_OMIX);
#pragma unroll
  for (int t = 0; t < NT; ++t) {
    float l = lrun[t];
    l += __shfl_xor(l, 16);
    l += __shfl_xor(l, 32);
    float inv = 1.f / l;
    u16* op = omix + (size_t)(seq0 + rb + RS * t + 16 * iq) * 1024 + h * 64 + quad * 4;
#pragma unroll
    for (int dt = 0; dt < 4; ++dt) {
      uint2 w; w.x = pack2(o[t][dt][0] * inv, o[t][dt][1] * inv); w.y = pack2(o[t][dt][2] * inv, o[t][dt][3] * inv);
      *(uint2*)(op + dt * 16) = w;
    }
  }
}

constexpr int ATT_NT = 4;
__device__ void phase_attn(const P& p) {
  int wid = __builtin_amdgcn_readfirstlane(opaque_tid(p) >> 6);
  for (int u = blockIdx.x * 8 + wid; u < 32768 / ATT_NT; u += gridDim.x * 8) attn_unitN<ATT_NT>(p, u);
}

constexpr int LP = 72;
constexpr int G_BF = 0;
constexpr int G_BB = G_BF + 64 * 65 * 4;
constexpr int G_T0 = G_BB + 64 * 65 * 4;
constexpr int G_T1 = G_T0 + 64 * LP * 2;
constexpr int G_T2 = G_T1 + 64 * LP * 2;
constexpr int G_T3 = G_T2 + 64 * LP * 2;
constexpr int G_VT = G_T3 + 64 * LP * 2;
constexpr int G_ATT = G_VT + 128 * LP * 2;
constexpr int G_SSQ = G_ATT + 64 * LP * 2;
constexpr int G_SEG = G_SSQ + 512;

#define LBAR do { asm volatile("s_waitcnt lgkmcnt(0)" ::: "memory"); __builtin_amdgcn_s_barrier(); } while (0)
__device__ __forceinline__ void gla_cumsum(const P& p, uint4 a, uint4 b, char* sm) {
  float* bF = (float*)(sm + G_BF);
  float* bB = (float*)(sm + G_BB);
  int tid = opaque_tid(p);
  {
    int s = tid >> 3, d0 = (tid & 7) * 8;
    const u16* pa = (const u16*)&a; const u16* pb = (const u16*)&b;
#pragma unroll
    for (int e = 0; e < 8; ++e) { bF[s * 65 + d0 + e] = bf2f(pa[e]); bB[s * 65 + d0 + e] = bf2f(pb[e]); }
  }
  LBAR;
  {
    float* segF = (float*)(sm + G_SEG);
    float* segB = segF + 8 * 64;
    int dk = tid & 63, seg = tid >> 6;
    float a = 0.f, c = 0.f;
#pragma unroll
    for (int i = 0; i < 8; ++i) { a += bF[(seg * 8 + i) * 65 + dk]; bF[(seg * 8 + i) * 65 + dk] = a; }
#pragma unroll
    for (int i = 7; i >= 0; --i) { c += bB[(seg * 8 + i) * 65 + dk]; bB[(seg * 8 + i) * 65 + dk] = c; }
    segF[seg * 64 + dk] = a; segB[seg * 64 + dk] = c;
    LBAR;
    float offF = 0.f, offB = 0.f;
#pragma unroll
    for (int s2 = 0; s2 < 8; ++s2) {
      float f = segF[s2 * 64 + dk], g = segB[s2 * 64 + dk];
      offF += (s2 < seg) ? f : 0.f;
      offB += (s2 > seg) ? g : 0.f;
    }
#pragma unroll
    for (int i = 0; i < 8; ++i) { bF[(seg * 8 + i) * 65 + dk] += offF; bB[(seg * 8 + i) * 65 + dk] += offB; }
  }
  LBAR;
}

struct SummRaw { uint4 laf, lab, k, v0, v1; };
__device__ __forceinline__ SummRaw gla_summ_load(const P& p, int unit, int tid) {
  SummRaw r;
  int chunk = unit >> 2, h = unit & 3;
  { int s = tid >> 3, d0 = (tid & 7) * 8;
    size_t g = (size_t)(chunk * 64 + s) * 256 + h * 64 + d0;
    r.laf = *(const uint4*)((const u16*)(p.ws + OFF_LAF) + g);
    r.lab = *(const uint4*)((const u16*)(p.ws + OFF_LAB) + g); }
  { int s = tid & 63, dg = tid >> 6;
    r.k = *(const uint4*)((const u16*)(p.ws + OFF_KA) + (size_t)(chunk * 64 + s) * 256 + h * 64 + dg * 8); }
  const u16* vsrc = (const u16*)(p.ws + OFF_VAT) + (size_t)unit * 8192;
  r.v0 = *(const uint4*)(vsrc + (tid >> 3) * 64 + (tid & 7) * 8);
  r.v1 = *(const uint4*)(vsrc + ((tid + 512) >> 3) * 64 + (tid & 7) * 8);
  return r;
}

__device__ __forceinline__ void gla_summ_unit(const P& p, int unit, const SummRaw& raw) {
  extern __shared__ __attribute__((aligned(16))) u16 shm[];
  char* sm = (char*)shm;
  int tid = opaque_tid(p), lane = tid & 63, wid = tid >> 6;
  gla_cumsum(p, raw.laf, raw.lab, sm);
  float* bF = (float*)(sm + G_BF);
  float* bB = (float*)(sm + G_BB);
  u16* kdfT = (u16*)(sm + G_T0);
  u16* kdbT = (u16*)(sm + G_T1);
  u16* vT = (u16*)(sm + G_VT);
  {
    int s = tid & 63, dg = tid >> 6;
    const u16* pk = (const u16*)&raw.k;
#pragma unroll
    for (int e = 0; e < 8; ++e) {
      int dk = dg * 8 + e;
      float k = bf2f(pk[e]);
      kdfT[dk * LP + s] = f2bf(k * __expf(bF[63 * 65 + dk] - bF[s * 65 + dk]));
      kdbT[dk * LP + s] = f2bf(k * __expf(bB[0 * 65 + dk] - bB[s * 65 + dk]));
    }
    *(uint4*)(vT + (tid >> 3) * LP + (tid & 7) * 8) = raw.v0;
    *(uint4*)(vT + ((tid + 512) >> 3) * LP + (tid & 7) * 8) = raw.v1;
    if (tid < 128) {
      int dir = tid >> 6, dk = tid & 63;
      float* dec = (float*)(p.ws + OFF_DEC);
      dec[(size_t)(unit * 2 + dir) * 64 + dk] = __expf(dir == 0 ? bF[63 * 65 + dk] : bB[dk]);
    }
  }
  LBAR;
  u16* kvout = (u16*)((char*)p.out + OUT_KV);
  int fr = lane & 15, fq = lane >> 4;
#pragma unroll 1
  for (int tI = 0; tI < 8; ++tI) {
    int tile = wid * 8 + tI;
    int dir = tile >> 5, dkt = (tile >> 3) & 3, dvt = tile & 7;
    const u16* Asrc = (dir ? kdbT : kdfT) + (dkt * 16 + fr) * LP + fq * 8;
    const u16* Bsrc = vT + (dvt * 16 + fr) * LP + fq * 8;
    f32x4 d = {0.f, 0.f, 0.f, 0.f};
#pragma unroll
    for (int ks = 0; ks < 2; ++ks) {
      bf16x8 a = *(const bf16x8*)(Asrc + ks * 32);
      bf16x8 b = *(const bf16x8*)(Bsrc + ks * 32);
      d = __builtin_amdgcn_mfma_f32_16x16x32_bf16(a, b, d, 0, 0, 0);
    }
    uint2 w; w.x = pack2(d[0], d[1]); w.y = pack2(d[2], d[3]);
    *(uint2*)(kvout + (size_t)(unit * 2 + dir) * 8192 + (dvt * 16 + fr) * 64 + dkt * 16 + fq * 4) = w;
  }
  LBAR;
}

__device__ void phase_gla_summ(const P& p) {
  int tid = opaque_tid(p);
  int u = blockIdx.x;
  if (u >= 4096) return;
  SummRaw cur = gla_summ_load(p, u, tid);
  for (; u < 4096; u += gridDim.x) {
    int un = u + gridDim.x;
    SummRaw nxt = gla_summ_load(p, un < 4096 ? un : u, tid);
    gla_summ_unit(p, u, cur);
    cur = nxt;
  }
}

__device__ void phase_gla_scan(const P& p) {
  u16* kv = (u16*)((char*)p.out + OUT_KV);
  const float* dec = (const float*)(p.ws + OFF_DEC);
  int tid = opaque_tid(p);
  for (int it = blockIdx.x; it < 768; it += gridDim.x) {
    int chunk0, nc, q;
    if (it < 256) { q = it; int seq = q >> 6; chunk0 = 512 + seq * 128; nc = 128; q &= 63; }
    else { q = it - 256; int seq = q >> 6; chunk0 = seq * 64; nc = 64; q &= 63; }
    int h = q >> 4, dir = (q >> 3) & 1, sl = q & 7;
    int e0 = sl * 1024 + tid * 2;
    int dk = e0 & 63;
    float s0 = 0.f, s1 = 0.f;
    for (int n8 = 0; n8 < nc; n8 += 8) {
      unsigned kvv[8]; float2 dd[8];
#pragma unroll
      for (int i = 0; i < 8; ++i) {
        int n = n8 + i;
        int chunk = dir == 0 ? chunk0 + n : chunk0 + nc - 1 - n;
        size_t base = (size_t)((chunk * 4 + h) * 2 + dir);
        kvv[i] = *(const unsigned*)(kv + base * 8192 + e0);
        dd[i] = *(const float2*)(dec + base * 64 + dk);
      }
#pragma unroll
      for (int i = 0; i < 8; ++i) {
        int n = n8 + i;
        int chunk = dir == 0 ? chunk0 + n : chunk0 + nc - 1 - n;
        size_t base = (size_t)((chunk * 4 + h) * 2 + dir);
        *(unsigned*)(kv + base * 8192 + e0) = pack2(s0, s1);
        s0 = dd[i].x * s0 + bf2f((u16)(kvv[i] & 0xffff));
        s1 = dd[i].y * s1 + bf2f((u16)(kvv[i] >> 16));
      }
    }
  }
}

struct OutRaw { uint4 laf, lab, q, k, v0, v1; };
__device__ __forceinline__ OutRaw gla_out_load(const P& p, int unit, int tid) {
  OutRaw r;
  int chunk = unit >> 2, h = unit & 3;
  int s = tid >> 3, d0 = (tid & 7) * 8;
  size_t g = (size_t)(chunk * 64 + s) * 256 + h * 64 + d0;
  r.laf = *(const uint4*)((const u16*)(p.ws + OFF_LAF) + g);
  r.lab = *(const uint4*)((const u16*)(p.ws + OFF_LAB) + g);
  r.q = *(const uint4*)((const u16*)(p.ws + OFF_QA) + g);
  r.k = *(const uint4*)((const u16*)(p.ws + OFF_KA) + g);
  const u16* vsrc = (const u16*)(p.ws + OFF_VAT) + (size_t)unit * 8192;
  r.v0 = *(const uint4*)(vsrc + (tid >> 3) * 64 + (tid & 7) * 8);
  r.v1 = *(const uint4*)(vsrc + ((tid + 512) >> 3) * 64 + (tid & 7) * 8);
  return r;
}

__device__ __forceinline__ void gla_out_unit(const P& p, int unit, const OutRaw& raw) {
  extern __shared__ __attribute__((aligned(16))) u16 shm[];
  char* sm = (char*)shm;
  int chunk = unit >> 2, h = unit & 3;
  int tid = opaque_tid(p), lane = tid & 63, wid = tid >> 6;
  bf16x8 sB[4][2][2];
  uint2 rav[4];
  {
    int fr = lane & 15, fq = lane >> 4, tt = wid >> 1, dvh = wid & 1;
    const u16* Sst = (const u16*)((const char*)p.out + OUT_KV) + (size_t)(unit * 2) * 8192;
    const u16* ra = (const u16*)(p.ws + OFF_RA);
#pragma unroll
    for (int i = 0; i < 4; ++i) {
      int dvt = dvh * 4 + i;
#pragma unroll
      for (int ks = 0; ks < 2; ++ks) {
        sB[i][ks][0] = *(const bf16x8*)(Sst + (dvt * 16 + fr) * 64 + ks * 32 + fq * 8);
        sB[i][ks][1] = *(const bf16x8*)(Sst + 8192 + (dvt * 16 + fr) * 64 + ks * 32 + fq * 8);
      }
      rav[i] = *(const uint2*)(ra + ((size_t)unit * 128 + dvt * 16 + fr) * 64 + tt * 16 + fq * 4);
    }
  }
  gla_cumsum(p, raw.laf, raw.lab, sm);
  float* bF = (float*)(sm + G_BF);
  float* bB = (float*)(sm + G_BB);
  u16* qf = (u16*)(sm + G_T0);
  u16* qb = (u16*)(sm + G_T1);
  u16* kf = (u16*)(sm + G_T2);
  u16* kb = (u16*)(sm + G_T3);
  u16* vT = (u16*)(sm + G_VT);
  u16* att = (u16*)(sm + G_ATT);
  float* ssq = (float*)(sm + G_SSQ);
  {
    int s = tid >> 3, d0 = (tid & 7) * 8;
    const u16* pq = (const u16*)&raw.q; const u16* pk = (const u16*)&raw.k;
    u16 oqf[8], oqb[8], okf[8], okb[8];
#pragma unroll
    for (int e = 0; e < 8; ++e) {
      float bf = bF[s * 65 + d0 + e], bb = bB[s * 65 + d0 + e];
      float qq = bf2f(pq[e]), kk = bf2f(pk[e]);
      oqf[e] = f2bf(qq * __expf(bf)); oqb[e] = f2bf(qq * __expf(bb));
      okf[e] = f2bf(kk * __expf(-bf)); okb[e] = f2bf(kk * __expf(-bb));
    }
    *(uint4*)(qf + s * LP + d0) = *(const uint4*)oqf;
    *(uint4*)(qb + s * LP + d0) = *(const uint4*)oqb;
    *(uint4*)(kf + s * LP + d0) = *(const uint4*)okf;
    *(uint4*)(kb + s * LP + d0) = *(const uint4*)okb;
    *(uint4*)(vT + (tid >> 3) * LP + (tid & 7) * 8) = raw.v0;
    *(uint4*)(vT + ((tid + 512) >> 3) * LP + (tid & 7) * 8) = raw.v1;
  }
  LBAR;
  int fr = lane & 15, fq = lane >> 4;
#pragma unroll 1
  for (int tI = 0; tI < 2; ++tI) {
    int tile = wid * 2 + tI; int tt = tile >> 2, st = tile & 3;
    f32x4 df = {0.f, 0.f, 0.f, 0.f}, db = {0.f, 0.f, 0.f, 0.f};
#pragma unroll
    for (int ks = 0; ks < 2; ++ks) {
      bf16x8 a = *(const bf16x8*)(qf + (tt * 16 + fr) * LP + ks * 32 + fq * 8);
      bf16x8 b = *(const bf16x8*)(kf + (st * 16 + fr) * LP + ks * 32 + fq * 8);
      df = __builtin_amdgcn_mfma_f32_16x16x32_bf16(a, b, df, 0, 0, 0);
      bf16x8 a2 = *(const bf16x8*)(qb + (tt * 16 + fr) * LP + ks * 32 + fq * 8);
      bf16x8 b2 = *(const bf16x8*)(kb + (st * 16 + fr) * LP + ks * 32 + fq * 8);
      db = __builtin_amdgcn_mfma_f32_16x16x32_bf16(a2, b2, db, 0, 0, 0);
    }
    int s = st * 16 + fr;
#pragma unroll
    for (int j = 0; j < 4; ++j) {
      int t = tt * 16 + fq * 4 + j;
      float v = (s <= t) ? df[j] : db[j];
      att[t * LP + s] = f2bf(v);
    }
  }
  LBAR;
  int tt = wid >> 1, dvh = wid & 1;
  f32x4 o[4];
  float sq[4] = {0.f, 0.f, 0.f, 0.f};
#pragma unroll
  for (int i = 0; i < 4; ++i) {
    int dvt = dvh * 4 + i;
    f32x4 d = {0.f, 0.f, 0.f, 0.f};
#pragma unroll
    for (int ks = 0; ks < 2; ++ks) {
      bf16x8 a = *(const bf16x8*)(att + (tt * 16 + fr) * LP + ks * 32 + fq * 8);
      bf16x8 b = *(const bf16x8*)(vT + (dvt * 16 + fr) * LP + ks * 32 + fq * 8);
      d = __builtin_amdgcn_mfma_f32_16x16x32_bf16(a, b, d, 0, 0, 0);
      bf16x8 a1 = *(const bf16x8*)(qf + (tt * 16 + fr) * LP + ks * 32 + fq * 8);
      bf16x8 b1 = sB[i][ks][0];
      d = __builtin_amdgcn_mfma_f32_16x16x32_bf16(a1, b1, d, 0, 0, 0);
      bf16x8 a2 = *(const bf16x8*)(qb + (tt * 16 + fr) * LP + ks * 32 + fq * 8);
      bf16x8 b2 = sB[i][ks][1];
      d = __builtin_amdgcn_mfma_f32_16x16x32_bf16(a2, b2, d, 0, 0, 0);
    }
    o[i] = d;
#pragma unroll
    for (int j = 0; j < 4; ++j) sq[j] += d[j] * d[j];
  }
#pragma unroll
  for (int j = 0; j < 4; ++j) {
    float v = sq[j];
    v = row16_sum(v);
    sq[j] = v;
  }
  if (fr == 0) {
#pragma unroll
    for (int j = 0; j < 4; ++j) ssq[(tt * 16 + fq * 4 + j) * 2 + dvh] = sq[j];
  }
  LBAR;
  u16* omix = (u16*)(p.ws + OFF_OMIX);
  {
    float rsj[4];
#pragma unroll
    for (int j = 0; j < 4; ++j) {
      int t = tt * 16 + fq * 4 + j;
      float tot = ssq[t * 2] + ssq[t * 2 + 1];
      rsj[j] = rsqrtf(tot * (1.f / 128.f) + 1e-6f);
    }
    int row0 = chunk * 64 + tt * 16 + fq * 4;
#pragma unroll
    for (int i = 0; i < 4; ++i) {
      int dv = (dvh * 4 + i) * 16 + fr;
      float g = p.g_gla[dv];
      float s0 = __uint_as_float(rav[i].x << 16), s1 = __uint_as_float(rav[i].x & 0xffff0000u);
      float s2 = __uint_as_float(rav[i].y << 16), s3 = __uint_as_float(rav[i].y & 0xffff0000u);
      store_rm4(omix, 1024, row0, 512 + h * 128 + dv, o[i][0] * rsj[0] * g * s0, o[i][1] * rsj[1] * g * s1,
                o[i][2] * rsj[2] * g * s2, o[i][3] * rsj[3] * g * s3, fr & 1);
    }
  }
  LBAR;
}

__device__ void phase_gla_out(const P& p) {
  int tid = opaque_tid(p);
  int u = blockIdx.x;
  if (u >= 4096) return;
  OutRaw cur = gla_out_load(p, u, tid);
  for (; u < 4096; u += gridDim.x) {
    int un = u + gridDim.x;
    OutRaw nxt = gla_out_load(p, un < 4096 ? un : u, tid);
    gla_out_unit(p, u, cur);
    cur = nxt;
  }
}

__device__ __forceinline__ void ssq_store(float (&sq)[2][4][4], float* dstbase, int brow, int slot, int wr, int fr, int fq) {
#pragma unroll
  for (int ai = 0; ai < 2; ++ai)
#pragma unroll
    for (int m = 0; m < 4; ++m)
#pragma unroll
      for (int j = 0; j < 4; ++j) {
        float v = sq[ai][m][j];
        v = row16_sum(v);
        if (fr == 0) dstbase[(size_t)(brow + ai * 128 + wr * 64 + m * 16 + fq * 4 + j) * 16 + slot] = v;
      }
}

struct EpiOut {
  P p; static constexpr bool twice = false;
  __device__ __forceinline__ void operator()(f32x4 (&acc)[2][2][4][2], int brow, int bcol, int wr, int wc, int fr, int fq) const {
    u16* x1b = (u16*)(p.ws + OFF_X1B);
    float* ssq1 = (float*)(p.ws + OFF_SSQ1);
    int slot = (bcol >> 8) * 4 + wc;
    const bool odd = fr & 1;
    const int o1 = odd ? 1 : 0;
    float2 tc[4][2], tn[4][2];
    {
      const float* xb0 = xrow(p, brow + wr * 64 + fq * 4);
#pragma unroll
      for (int q = 0; q < 4; ++q)
#pragma unroll
        for (int pr = 0; pr < 2; ++pr)
          tc[q][pr] = *(const float2*)(xb0 + (size_t)(2 * pr + o1) * 1024 + (bcol + (q >> 1) * 128 + wc * 32 + (q & 1) * 16 + fr - o1));
    }
#pragma unroll
    for (int ch = 0; ch < 8; ++ch) {
      const int ai = ch >> 2, m = ch & 3;
      int row0 = brow + ai * 128 + wr * 64 + m * 16 + fq * 4;
      if (ch + 1 < 8) {
        const float* xbn = xrow(p, brow + ((ch + 1) >> 2) * 128 + wr * 64 + ((ch + 1) & 3) * 16 + fq * 4);
#pragma unroll
        for (int q = 0; q < 4; ++q)
#pragma unroll
          for (int pr = 0; pr < 2; ++pr)
            tn[q][pr] = *(const float2*)(xbn + (size_t)(2 * pr + o1) * 1024 + (bcol + (q >> 1) * 128 + wc * 32 + (q & 1) * 16 + fr - o1));
      }
      __builtin_amdgcn_sched_barrier(0);
      float sq[4] = {0.f, 0.f, 0.f, 0.f};
#pragma unroll
      for (int q = 0; q < 4; ++q) {
        const int bj = q >> 1, n = q & 1;
        int c = bcol + bj * 128 + wc * 32 + n * 16 + fr;
        float v[4];
#pragma unroll
        for (int pr = 0; pr < 2; ++pr) {
          float2 t = tc[q][pr];
          float r = dpp_swap1(odd ? t.x : t.y);
          v[2 * pr] = odd ? r : t.x; v[2 * pr + 1] = odd ? t.y : r;
        }
#pragma unroll
        for (int j = 0; j < 4; ++j) { v[j] += acc[ai][bj][m][n][j]; sq[j] += v[j] * v[j]; }
        store_rm4(x1b, 1024, row0, c, v[0], v[1], v[2], v[3], odd);
      }
#pragma unroll
      for (int j = 0; j < 4; ++j) {
        float t = row16_sum(sq[j]);
        if (fr == 0) ssq1[(size_t)(row0 + j) * 16 + slot] = t;
      }
      __builtin_amdgcn_sched_barrier(0);
#pragma unroll
      for (int q = 0; q < 4; ++q) { tc[q][0] = tn[q][0]; tc[q][1] = tn[q][1]; }
    }
  }
};

struct EpiGU {
  P p; static constexpr bool twice = false;
  __device__ __forceinline__ void operator()(f32x4 (&acc)[2][2][4][2], int brow, int bcol, int wr, int wc, int fr, int fq) const {
    const float* ssq1 = (const float*)(p.ws + OFF_SSQ1);
    u16* act = (u16*)(p.ws + OFF_ACT);
    int t = bcol >> 8;
    float sv[2][4][4];
#pragma unroll
    for (int ai = 0; ai < 2; ++ai)
#pragma unroll
      for (int m = 0; m < 4; ++m)
#pragma unroll
        for (int j = 0; j < 4; ++j) sv[ai][m][j] = ssq1[(size_t)(brow + ai * 128 + wr * 64 + m * 16 + fq * 4 + j) * 16 + fr];
    __builtin_amdgcn_sched_barrier(0);
#pragma unroll
    for (int ai = 0; ai < 2; ++ai)
#pragma unroll
      for (int m = 0; m < 4; ++m) {
        int row0 = brow + ai * 128 + wr * 64 + m * 16 + fq * 4;
        float rs[4];
#pragma unroll
        for (int j = 0; j < 4; ++j) rs[j] = rsqrtf(row16_sum(sv[ai][m][j]) * (1.f / 1024.f) + 1e-6f);
#pragma unroll
        for (int n = 0; n < 2; ++n) {
          float a[4];
#pragma unroll
          for (int j = 0; j < 4; ++j) {
            float g = acc[ai][0][m][n][j] * rs[j], u = acc[ai][1][m][n][j] * rs[j];
            a[j] = fast_silu(g) * u;
          }
          store_rm4(act, 2816, row0, t * 128 + wc * 32 + n * 16 + fr, a[0], a[1], a[2], a[3], fr & 1);
        }
        __builtin_amdgcn_sched_barrier(0);
      }
  }
};

struct EpiDown {
  P p;
  __device__ __forceinline__ void operator()(f32x4 (&acc)[2][2][4][2], int brow, int bcol, int wr, int wc, int fr, int fq) const {
    const u16* x1b = (const u16*)(p.ws + OFF_X1B);
    float sq[2][4][4];
#pragma unroll
    for (int ai = 0; ai < 2; ++ai)
#pragma unroll
      for (int m = 0; m < 4; ++m) {
        int row0 = brow + ai * 128 + wr * 64 + m * 16 + fq * 4;
#pragma unroll
        for (int j = 0; j < 4; ++j) {
          float s = 0.f;
#pragma unroll
          for (int bj = 0; bj < 2; ++bj)
#pragma unroll
            for (int n = 0; n < 2; ++n) {
              int c = bcol + bj * 128 + wc * 32 + n * 16 + fr;
              size_t o = (size_t)(row0 + j) * 1024 + c;
              float v = bf2f(x1b[o]) + acc[ai][bj][m][n][j];
              p.out[o] = v;
              s += v * v;
            }
          sq[ai][m][j] = s;
        }
      }
    ssq_store(sq, (float*)(p.ws + OFF_SSQ2), brow, (bcol >> 8) * 4 + wc, wr, fr, fq);
  }
};

struct EpiDownF {
  P p; static constexpr bool twice = false;
  __device__ __forceinline__ void operator()(f32x4 (&acc)[2][2][4][2], int brow, int bcol, int wr, int wc, int fr, int fq) const {
    extern __shared__ __attribute__((aligned(16))) u16 shm[];
    float* part = (float*)((char*)shm + 3 * HT * 2);
    float* rsl = part + 1024;
    const u16* x1b = (const u16*)(p.ws + OFF_X1B);
    unsigned long long* gran = (unsigned long long*)(p.ws + OFF_SSQ2);
    int ntile = bcol >> 8;
    int tid = (wr * 4 + wc) * 64 + fq * 16 + fr;
#pragma unroll
    for (int ai = 0; ai < 2; ++ai)
#pragma unroll
      for (int m = 0; m < 4; ++m) {
        int rl0 = ai * 128 + wr * 64 + m * 16 + fq * 4;
        float sq[4] = {0.f, 0.f, 0.f, 0.f};
#pragma unroll
        for (int bj = 0; bj < 2; ++bj)
#pragma unroll
          for (int n = 0; n < 2; ++n) {
            int c = bcol + bj * 128 + wc * 32 + n * 16 + fr;
            float xv[4];
            load_rm4_bf16(x1b + (size_t)(brow + rl0) * 1024, 1024, c, fr & 1, xv);
#pragma unroll
            for (int j = 0; j < 4; ++j) {
              float v = xv[j] + acc[ai][bj][m][n][j];
              acc[ai][bj][m][n][j] = v;
              sq[j] += v * v;
            }
          }
#pragma unroll
        for (int j = 0; j < 4; ++j) {
          float s = sq[j];
          s = row16_sum(s);
          if (fr == 0) part[(rl0 + j) * 4 + wc] = s;
        }
        __builtin_amdgcn_sched_barrier(0);
      }
    __syncthreads();
    if (tid < 256) {
      float s = part[tid * 4] + part[tid * 4 + 1] + part[tid * 4 + 2] + part[tid * 4 + 3];
      unsigned long long g = (unsigned long long)__float_as_uint(s) | (1ull << 32);
      __hip_atomic_store(gran + (size_t)(brow + tid) * 4 + ntile, g, __ATOMIC_RELAXED, __HIP_MEMORY_SCOPE_AGENT);
    }
    asm volatile("s_waitcnt vmcnt(0)" ::: "memory");
    __syncthreads();
    unsigned* cnt = (unsigned*)(p.ws + OFF_CNT) + (brow >> 8);
    if (tid == 0) {
      __hip_atomic_fetch_add(cnt, 1u, __ATOMIC_RELAXED, __HIP_MEMORY_SCOPE_AGENT);
      while (__hip_atomic_load(cnt, __ATOMIC_RELAXED, __HIP_MEMORY_SCOPE_AGENT) < 4u) __builtin_amdgcn_s_sleep(2);
    }
    __syncthreads();
    if (tid < 256) {
      float tot = 0.f;
#pragma unroll
      for (int q = 0; q < 4; ++q) {
        unsigned long long g;
        do { g = __hip_atomic_load(gran + (size_t)(brow + tid) * 4 + q, __ATOMIC_RELAXED, __HIP_MEMORY_SCOPE_AGENT); } while ((unsigned)(g >> 32) != 1u);
        tot += __uint_as_float((unsigned)g);
      }
      rsl[tid] = rsqrtf(tot * (1.f / 1024.f) + 1e-6f);
    }
    __syncthreads();
#pragma unroll
    for (int ai = 0; ai < 2; ++ai)
#pragma unroll
      for (int m = 0; m < 4; ++m) {
        int rl0 = ai * 128 + wr * 64 + m * 16 + fq * 4;
        float4 r4 = *(const float4*)(rsl + rl0);
        float rr[4] = {r4.x, r4.y, r4.z, r4.w};
#pragma unroll
        for (int bj = 0; bj < 2; ++bj)
#pragma unroll
          for (int n = 0; n < 2; ++n) {
            int c = bcol + bj * 128 + wc * 32 + n * 16 + fr;
            float gf = p.g_final[c];
            store_rm4_f32(p.out + (size_t)(brow + rl0) * 1024, 1024, c, fr & 1, acc[ai][bj][m][n][0] * rr[0] * gf,
                          acc[ai][bj][m][n][1] * rr[1] * gf, acc[ai][bj][m][n][2] * rr[2] * gf, acc[ai][bj][m][n][3] * rr[3] * gf);
          }
        __builtin_amdgcn_sched_barrier(0);
      }
  }
};

__device__ void phase_final(const P& p) {
  int tid = opaque_tid(p); int lane = tid & 63, wid = tid >> 6;
  const float* ssq2 = (const float*)(p.ws + OFF_SSQ2);
  for (int row = blockIdx.x * 8 + wid; row < NTOK; row += gridDim.x * 8) {
    float v = ssq2[(size_t)row * 16 + (lane & 15)];
    v = row16_sum(v);
    float rs = rsqrtf(v * (1.f / 1024.f) + 1e-6f);
    float4* o = (float4*)(p.out + (size_t)row * 1024);
    const float4* g = (const float4*)p.g_final;
#pragma unroll
    for (int i = 0; i < 4; ++i) {
      float4 x = o[lane + i * 64], gg = g[lane + i * 64];
      x.x *= rs * gg.x; x.y *= rs * gg.y; x.z *= rs * gg.z; x.w *= rs * gg.w;
      o[lane + i * 64] = x;
    }
  }
}

#define XB_TMO      128
#define XB_XCNT(j)  (256  + 64 * (j))
#define XB_XSUB(j)  (1280 + 64 * (j))
#define XB_XGEN(j)  (2304 + 64 * (j))
#define XB_TOP      3328
#define XB_TOPGEN   3392
#define XCD_BAR_WORDS 3456
#define XB_SPIN_CAP (1u << 18)
#define LAS __attribute__((address_space(3)))
__device__ __forceinline__ unsigned xb_ld(unsigned* q)              { return __hip_atomic_load(q, __ATOMIC_RELAXED, __HIP_MEMORY_SCOPE_AGENT); }
__device__ __forceinline__ unsigned xb_add(unsigned* q, unsigned v) { return __hip_atomic_fetch_add(q, v, __ATOMIC_RELAXED, __HIP_MEMORY_SCOPE_AGENT); }
__device__ __forceinline__ unsigned xb_xcc_id() { return (unsigned)__builtin_amdgcn_s_getreg((3 << 11) | 20) & 0xFu; }
#define XB_SPIN(cond, bar) do { unsigned _sp = 0; while (cond) { __builtin_amdgcn_s_sleep(1); \
    if ((++_sp & 255u) == 0u) { if (xb_ld(&(bar)[XB_TMO])) break; if (_sp > XB_SPIN_CAP) { atomicAdd(&(bar)[XB_TMO], 1u); break; } } } } while (0)
struct XcdBarrier { unsigned* bar; unsigned x; volatile LAS unsigned* st; };

__device__ __forceinline__ void xcd_barrier_complete(unsigned* bar, unsigned x, unsigned& nloc, unsigned& nx) {
  const unsigned G = gridDim.x * gridDim.y * gridDim.z;
  unsigned sum, cnt, mine, sp = 0u;
  for (;;) {
    sum = 0u; cnt = 0u; mine = 0u;
#pragma unroll
    for (unsigned j = 0; j < 16; ++j) { const unsigned c = xb_ld(&bar[XB_XCNT(j)]); sum += c; cnt += (c > 0u) ? 1u : 0u; mine = (j == x) ? c : mine; }
    if (sum == G) break;
    __builtin_amdgcn_s_sleep(1);
    if ((++sp & 255u) == 0u) { if (xb_ld(&bar[XB_TMO])) break; if (sp > XB_SPIN_CAP) { atomicAdd(&bar[XB_TMO], 1u); break; } }
  }
  nloc = mine > 0u ? mine : 1u; nx = cnt > 0u ? cnt : 1u;
}

__device__ __forceinline__ void xcd_barrier(const XcdBarrier& b, const P& p) {
  asm volatile("s_waitcnt vmcnt(0)" ::: "memory");
  __syncthreads();
  if (opaque_tid(p) == 0) {
    unsigned* bar = b.bar;
    __builtin_amdgcn_s_waitcnt(0);
    unsigned nloc = b.st[0], nx = b.st[1];
    if (nloc == 0u) { xcd_barrier_complete(bar, b.x, nloc, nx); b.st[0] = nloc; b.st[1] = nx; }
    const unsigned old = xb_add(&bar[XB_XSUB(b.x)], 1u);
    const unsigned gen = old / nloc;
    if (old + 1u == (gen + 1u) * nloc) {
      __builtin_amdgcn_fence(__ATOMIC_RELEASE, "agent");
      asm volatile("s_waitcnt vmcnt(0)" ::: "memory");
      const unsigned og = xb_add(&bar[XB_TOP], 1u);
      const unsigned tg = og / nx;
      if (og + 1u == (tg + 1u) * nx) xb_add(&bar[XB_TOPGEN], 1u);
      else XB_SPIN(xb_ld(&bar[XB_TOPGEN]) == tg, bar);
      __builtin_amdgcn_fence(__ATOMIC_ACQUIRE, "agent");
      xb_add(&bar[XB_XGEN(b.x)], 1u);
      asm volatile("s_waitcnt vmcnt(0)" ::: "memory");
    } else {
      XB_SPIN(xb_ld(&bar[XB_XGEN(b.x)]) == gen, bar);
      __builtin_amdgcn_fence(__ATOMIC_ACQUIRE, "agent");
      asm volatile("s_waitcnt vmcnt(0)" ::: "memory");
    }
  }
  __syncthreads();
}

__device__ __forceinline__ void run_phase(const P& p, int ph) {
  switch (ph) {
    case 0: phase_prep(p); break;
    case 1: gemm_phase((const u16*)(p.ws + OFF_XB), (const u16*)(p.ws + OFF_WIN), 1024, 13, EpiIn{p}); break;
    case 2: phase_gla_summ(p); phase_attn(p); break;
    case 3: phase_gla_scan(p); break;
    case 4: phase_gla_out(p); break;
    case 5: gemm_phase((const u16*)(p.ws + OFF_OMIX), (const u16*)(p.ws + OFF_WOUT), 1024, 4, EpiOut{p}); break;
    case 6: gemm_phase((const u16*)(p.ws + OFF_X1B), (const u16*)(p.ws + OFF_WGU), 1024, 22, EpiGU{p}); break;
#if MEGA && FUSE_FINAL
    case 7: gemm_phase((const u16*)(p.ws + OFF_ACT), (const u16*)(p.ws + OFF_WDN), 2816, 4, EpiDownF{p}); break;
    case 8: break;
#else
    case 7: gemm_phase((const u16*)(p.ws + OFF_ACT), (const u16*)(p.ws + OFF_WDN), 2816, 4, EpiDown{p}); break;
    case 8: phase_final(p); break;
#endif
    case 9: phase_attn(p); break;
    case 10: phase_gla_summ(p); break;
  }
}

#if MEGA
__global__ void __launch_bounds__(512) fwd_mega(P pin) {
  cg::grid_group grid = cg::this_grid();
  P p = pin; p.wv = __builtin_amdgcn_readfirstlane((int)(threadIdx.x >> 6));
  __shared__ uint4 xb_words;
  if (threadIdx.x == 0) {
    xb_words = make_uint4(0u, 0u, 0u, 0u);
  }
  __syncthreads();
  XcdBarrier xb;
  xb.bar = (unsigned*)(p.ws + OFF_BAR); xb.x = xb_xcc_id(); xb.st = (volatile LAS unsigned*)&xb_words;
  if (blockIdx.x == 0) for (int i = threadIdx.x; i < XCD_BAR_WORDS; i += 512) xb.bar[i] = 0u;
  p.vx = __builtin_amdgcn_readfirstlane((int)(blockIdx.x & 7)); p.vj = __builtin_amdgcn_readfirstlane((int)(blockIdx.x >> 3));
  grid.sync();
  if (threadIdx.x == 0) xb_words.z = xb_add(&xb.bar[XB_XCNT(xb.x)], 1u);
  run_phase(p, 0); xcd_barrier(xb, p);
  {
    if (opaque_tid(p) == 0) {
      bool ok = true;
#pragma unroll
      for (unsigned j = 0; j < 16; ++j) { unsigned c = xb_ld(&xb.bar[XB_XCNT(j)]); ok = ok && (c == (j < 8 ? 32u : 0u)); }
      xb_words.w = ok ? 1u : 0u;
    }
    __syncthreads();
    {
      int okf = __builtin_amdgcn_readfirstlane((int)xb_words.w);
      int zj = __builtin_amdgcn_readfirstlane((int)xb_words.z);
      bool use = okf != 0 && xb.x < 8u;
      int nvx = use ? (int)xb.x : p.vx, nvj = use ? zj : p.vj;
      p.vx = __builtin_amdgcn_readfirstlane(nvx); p.vj = __builtin_amdgcn_readfirstlane(nvj);
    }
    __syncthreads();
  }
  run_phase(p, 1); xcd_barrier(xb, p);
  run_phase(p, 2); xcd_barrier(xb, p);
  run_phase(p, 3); xcd_barrier(xb, p);
  run_phase(p, 4); xcd_barrier(xb, p);
  run_phase(p, 5); xcd_barrier(xb, p);
  run_phase(p, 6); xcd_barrier(xb, p);
  run_phase(p, 7);
#if !FUSE_FINAL
  xcd_barrier(xb, p); run_phase(p, 8);
#endif
}
#else
template <int PH>
__global__ void __launch_bounds__(512) fwd_phase(P pin) { P p = pin; p.wv = __builtin_amdgcn_readfirstlane((int)(threadIdx.x >> 6)); p.vx = (int)(blockIdx.x & 7); p.vj = (int)(blockIdx.x >> 3); run_phase(p, PH); }
#endif

extern "C" void kernel_launch(void* const* d_in, const int* in_sizes, int n_in, void* d_out, int out_size,
                              void* d_ws, size_t ws_size, hipStream_t stream) {
  if (ws_size < WS_NEED) { fprintf(stderr, "workspace too small: %zu\n", ws_size); return; }
  P p{};
  p.xp = (const float*)d_in[0]; p.xs = (const float*)d_in[1]; p.g_mix = (const float*)d_in[2];
  p.w_in = (const float*)d_in[3]; p.wgf = (const float*)d_in[4]; p.bgf = (const float*)d_in[5];
  p.wgb = (const float*)d_in[6]; p.bgb = (const float*)d_in[7]; p.g_gla = (const float*)d_in[8];
  p.w_out = (const float*)d_in[9]; p.g_ffn = (const float*)d_in[10]; p.w_fg = (const float*)d_in[11];
  p.w_fu = (const float*)d_in[12]; p.w_fd = (const float*)d_in[13]; p.g_final = (const float*)d_in[14];
  p.out = (float*)d_out; p.ws = (char*)d_ws;
#if MEGA
  static int grid_blocks = 0;
  if (!grid_blocks) {
    hipFuncSetAttribute((const void*)fwd_mega, hipFuncAttributeMaxDynamicSharedMemorySize, SHM_BYTES);
    int dev = 0, cus = 0, per_cu = 0;
    hipGetDevice(&dev);
    hipDeviceGetAttribute(&cus, hipDeviceAttributeMultiprocessorCount, dev);
    hipOccupancyMaxActiveBlocksPerMultiprocessor(&per_cu, fwd_mega, 512, SHM_BYTES);
    if (per_cu < 1) per_cu = 1;
    grid_blocks = cus * per_cu;
    if (grid_blocks > 256) grid_blocks = 256;
  }
  if (grid_blocks != 256) { fprintf(stderr, "need 256 resident blocks, have %d\n", grid_blocks); return; }
  void* args[] = {&p};
  hipError_t e = hipLaunchCooperativeKernel((const void*)fwd_mega, dim3(grid_blocks), dim3(512), args, SHM_BYTES, stream);
  if (e != hipSuccess) fprintf(stderr, "cooperative launch failed: %s (grid %d)\n", hipGetErrorString(e), grid_blocks);
#else
#define LAUNCH(PH) do { hipFuncSetAttribute((const void*)fwd_phase<PH>, hipFuncAttributeMaxDynamicSharedMemorySize, SHM_BYTES); \
    fwd_phase<PH><<<256, 512, SHM_BYTES, stream>>>(p); } while (0)
  LAUNCH(0); LAUNCH(1); LAUNCH(2); LAUNCH(3); LAUNCH(4); LAUNCH(5); LAUNCH(6); LAUNCH(7); LAUNCH(8);
#endif
}
```
